# Optimizing an MI355X kernel written in HIP

```python
import math
import jax, jax.numpy as jnp
from jax import lax
import numpy as np

D_MODEL = 1024
BATCH = 2
SEQ = 8192
DEPTH = 1

MIX_WIDTH = D_MODEL
GLA_HEADS = 4
GLA_DK = D_MODEL // 16
GLA_DV = D_MODEL // 8
GLA_KEY_WIDTH = GLA_HEADS * GLA_DK
GLA_WIDTH = GLA_HEADS * GLA_DV
GLA_GATE_RANK = 16
GLA_GATE_TEMP = 16.0
GLA_CHUNK = 64
SB_HEADS = 8
SB_DH = 64
SB_WIDTH = SB_HEADS * SB_DH
SB_BLOCK = 128
PEER_HEADS = 8
PEER_NKEYS = 128
PEER_NEXPERTS = PEER_NKEYS * PEER_NKEYS
PEER_QDIM = 256
PEER_HALF = PEER_QDIM // 2
PEER_TOPK = 16
PEER_TOKEN_BLOCK = 128
ALPHA = (2.0 * DEPTH) ** 0.25
BETA = (8.0 * DEPTH) ** -0.25
EPS = 1e-5

SPLIT_NAMES = ('q_gla', 'k_gla', 'v_gla', 'g_gla', 'a_gla', 'q_sb', 'k_sb', 'v_sb')
SPLIT_SIZES = (GLA_KEY_WIDTH, GLA_KEY_WIDTH, GLA_WIDTH, GLA_WIDTH, GLA_GATE_RANK,
               SB_WIDTH, SB_WIDTH, SB_WIDTH)
IN_WIDTH = sum(SPLIT_SIZES)
SPLIT_POINTS = [int(v) for v in np.cumsum(SPLIT_SIZES)[:-1]]

kernel_name = 'hybrid_gla_stickbreak_peer_deepnorm'


def layer_norm(x, g, b):
    xf = x.astype(jnp.float32)
    mu = jnp.mean(xf, axis=-1, keepdims=True)
    var = jnp.mean(jnp.square(xf - mu), axis=-1, keepdims=True)
    return ((xf - mu) * lax.rsqrt(var + EPS) * g + b).astype(x.dtype)


def rms_norm(x, g):
    xf = x.astype(jnp.float32)
    return (xf * lax.rsqrt(jnp.mean(xf * xf, axis=-1, keepdims=True) + EPS) * g).astype(x.dtype)


def gla_mixer(q, k, v, log_a):
    B, S = q.shape[0], q.shape[1]
    nc = S // GLA_CHUNK
    f32 = jnp.float32

    def to_chunks(t):
        return t.reshape(B, nc, GLA_CHUNK, t.shape[2], t.shape[3]).transpose(1, 0, 3, 2, 4).astype(f32)

    q, k, v, log_a = to_chunks(q) * (GLA_DK ** -0.5), to_chunks(k), to_chunks(v), to_chunks(log_a)
    b = jnp.cumsum(log_a, axis=-2)
    b_last = b[..., -1:, :]
    q_in = q * jnp.exp(b)
    k_in = k * jnp.exp(-b)
    k_state = k * jnp.exp(b_last - b)
    decay = jnp.exp(b_last)[..., 0, :, None]

    causal = jnp.tril(jnp.ones((GLA_CHUNK, GLA_CHUNK), dtype=bool))
    att = jnp.where(causal, jnp.einsum('nbhcd,nbhjd->nbhcj', q_in, k_in), 0.0)
    o_intra = jnp.einsum('nbhcj,nbhje->nbhce', att, v)

    def step(state, inp):
        qi, ks, vi, dec = inp
        o_inter = jnp.einsum('bhcd,bhde->bhce', qi, state)
        state = state * dec + jnp.einsum('bhjd,bhje->bhde', ks, vi)
        return state, o_inter

    state0 = jnp.zeros((B, q.shape[2], GLA_DK, GLA_DV), f32)
    _, o_inter = lax.scan(step, state0, (q_in, k_state, v, decay))
    o = o_intra + o_inter
    return o.transpose(1, 0, 3, 2, 4).reshape(B, S, GLA_HEADS, GLA_DV)


def stick_breaking(q, k, v):
    B, S, H, D = q.shape
    nb = S // SB_BLOCK
    scale = D ** -0.5
    qb = q.reshape(B, nb, SB_BLOCK, H, D).transpose(1, 0, 3, 2, 4)
    kT = k.transpose(0, 2, 1, 3)
    vT = v.transpose(0, 2, 1, 3)
    key_pos = jnp.arange(S)

    def block(args):
        qi, blk = args
        q_pos = blk * SB_BLOCK + jnp.arange(SB_BLOCK)
        z = jnp.einsum('bhqd,bhsd->bhqs', qi, kT).astype(jnp.float32) * scale
        mask = key_pos[None, :] < q_pos[:, None]
        log_not_break = jnp.where(mask, jax.nn.log_sigmoid(-z), 0.0)
        tail = lax.cumsum(log_not_break, axis=3, reverse=True) - log_not_break
        w = jnp.where(mask, jnp.exp(jax.nn.log_sigmoid(z) + tail), 0.0)
        return jnp.einsum('bhqs,bhsd->bhqd', w.astype(vT.dtype), vT)

    o = lax.map(block, (qb, jnp.arange(nb)))
    return o.transpose(1, 0, 3, 2, 4).reshape(B, S, H, D)


def hybrid_mixer(x, w_in, w_gla_gate, b_gla_gate, gla_norm_g, sb_norm_g, w_out):
    B, S, _ = x.shape
    proj = x @ w_in
    q_g, k_g, v_g, g_g, a_lr, q_s, k_s, v_s = jnp.split(proj, SPLIT_POINTS, axis=-1)

    log_a = jax.nn.log_sigmoid((a_lr @ w_gla_gate + b_gla_gate).astype(jnp.float32)) / GLA_GATE_TEMP
    o_gla = gla_mixer(q_g.reshape(B, S, GLA_HEADS, GLA_DK),
                      k_g.reshape(B, S, GLA_HEADS, GLA_DK),
                      v_g.reshape(B, S, GLA_HEADS, GLA_DV),
                      log_a.reshape(B, S, GLA_HEADS, GLA_DK))
    o_gla = rms_norm(o_gla, gla_norm_g).reshape(B, S, GLA_WIDTH).astype(x.dtype) * jax.nn.silu(g_g)

    o_sb = stick_breaking(q_s.reshape(B, S, SB_HEADS, SB_DH),
                          k_s.reshape(B, S, SB_HEADS, SB_DH),
                          v_s.reshape(B, S, SB_HEADS, SB_DH))
    o_sb = rms_norm(o_sb, sb_norm_g).reshape(B, S, SB_WIDTH).astype(x.dtype)

    return jnp.concatenate([o_gla, o_sb], axis=-1) @ w_out


def peer_ffn(x, w_query, sub_keys, expert_u, expert_v):
    B, S, D = x.shape
    T = B * S
    xt = x.reshape(T, D)
    qry = (xt @ w_query).reshape(T, PEER_HEADS, 2, PEER_HALF)
    scores = jnp.einsum('thpc,hpnc->thpn', qry, sub_keys).astype(jnp.float32)
    s_top, i_top = lax.top_k(scores, PEER_TOPK)
    cand = (s_top[:, :, 0, :, None] + s_top[:, :, 1, None, :]).reshape(T, PEER_HEADS, PEER_TOPK * PEER_TOPK)
    cand_idx = (i_top[:, :, 0, :, None] * PEER_NKEYS + i_top[:, :, 1, None, :]).reshape(T, PEER_HEADS, PEER_TOPK * PEER_TOPK)
    best, pos = lax.top_k(cand, PEER_TOPK)
    idx = jnp.take_along_axis(cand_idx, pos, axis=-1)
    gate = jax.nn.softmax(best, axis=-1)
    HK = PEER_HEADS * PEER_TOPK
    nb = T // PEER_TOKEN_BLOCK

    def block(args):
        xb, ib, gb = args
        u = expert_u[ib]
        h = jax.nn.gelu(jnp.einsum('tkd,td->tk', u, xb).astype(jnp.float32), approximate=False)
        vsel = expert_v[ib]
        return jnp.einsum('tk,tkd->td', (gb * h).astype(xb.dtype), vsel)

    out = lax.map(block, (xt.reshape(nb, PEER_TOKEN_BLOCK, D),
                          idx.reshape(nb, PEER_TOKEN_BLOCK, HK),
                          gate.reshape(nb, PEER_TOKEN_BLOCK, HK)))
    return out.reshape(B, S, D)


def setup_inputs(seed: int = 0) -> dict:
    key = jax.random.key(seed)
    ks = jax.random.split(key, 16)
    L, D = DEPTH, D_MODEL
    f32 = jnp.float32

    def nrm(k, shape, scale):
        return jax.random.normal(k, shape, f32) * scale

    col_scale = np.concatenate([np.full((s,), BETA if n in ('v_gla', 'v_sb') else 1.0, np.float32)
                                for n, s in zip(SPLIT_NAMES, SPLIT_SIZES)])
    return {
        'x': nrm(ks[0], (BATCH, SEQ, D), 1.0),
        'w_in': nrm(ks[1], (L, D, IN_WIDTH), D ** -0.5) * jnp.asarray(col_scale),
        'w_gla_gate': nrm(ks[2], (L, GLA_GATE_RANK, GLA_KEY_WIDTH), GLA_GATE_RANK ** -0.5),
        'b_gla_gate': nrm(ks[3], (L, GLA_KEY_WIDTH), 0.1),
        'gla_norm_g': 1.0 + nrm(ks[4], (L, GLA_HEADS, GLA_DV), 0.02),
        'sb_norm_g': 1.0 + nrm(ks[5], (L, SB_HEADS, SB_DH), 0.02),
        'w_out': nrm(ks[6], (L, MIX_WIDTH, D), MIX_WIDTH ** -0.5 * BETA),
        'ln1_g': 1.0 + nrm(ks[7], (L, D), 0.02),
        'ln1_b': nrm(ks[8], (L, D), 0.02),
        'peer_w_query': nrm(ks[9], (L, D, PEER_HEADS * PEER_QDIM), D ** -0.5),
        'peer_sub_keys': nrm(ks[10], (L, PEER_HEADS, 2, PEER_NKEYS, PEER_HALF), PEER_HALF ** -0.5),
        'peer_u': nrm(ks[11], (L, PEER_NEXPERTS, D), D ** -0.5 * BETA),
        'peer_v': nrm(ks[12], (L, PEER_NEXPERTS, D), BETA),
        'ln2_g': 1.0 + nrm(ks[13], (L, D), 0.02),
        'ln2_b': nrm(ks[14], (L, D), 0.02),
    }


def reference(x, w_in, w_gla_gate, b_gla_gate, gla_norm_g, sb_norm_g, w_out, ln1_g, ln1_b,
              peer_w_query, peer_sub_keys, peer_u, peer_v, ln2_g, ln2_b):
    for l in range(DEPTH):
        mix = hybrid_mixer(x, w_in[l], w_gla_gate[l], b_gla_gate[l], gla_norm_g[l], sb_norm_g[l], w_out[l])
        x = layer_norm(ALPHA * x + mix, ln1_g[l], ln1_b[l])
        ffn = peer_ffn(x, peer_w_query[l], peer_sub_keys[l], peer_u[l], peer_v[l])
        x = layer_norm(ALPHA * x + ffn, ln2_g[l], ln2_b[l])
    return x
```

```cpp
#include <hip/hip_runtime.h>
#include <cstdio>
#include <cstdint>

#ifndef MK_N_LAUNCHES
#define MK_N_LAUNCHES 1
#endif

#define GAS __attribute__((address_space(1)))
#define LAS __attribute__((address_space(3)))
typedef unsigned short bf16;
typedef unsigned v4u __attribute__((ext_vector_type(4)));
typedef unsigned v2u __attribute__((ext_vector_type(2)));
typedef float f32x4 __attribute__((ext_vector_type(4)));
typedef float f32x2 __attribute__((ext_vector_type(2)));

constexpr int BATCH = 2, SEQ = 8192, DM = 1024, T = BATCH * SEQ;
constexpr int INW = 3088, NPJ = 3072;
constexpr int C_QG = 0, C_KG = 256, C_VG = 512, C_GG = 1024, C_QS = 1536, C_KS = 2048, C_VS = 2560;
constexpr int A_COL = 1536;
constexpr float ALPHA = 1.18920711500272f;
constexpr float EPS = 1e-5f;
constexpr int NWAVES = 8, NTHR = 512;
constexpr int NPHASE = 8;

constexpr size_t MiB = 1u << 20;
constexpr size_t WS_CTL = 0, CTL_ZERO_BYTES = 1 * MiB;
constexpr size_t WS_WTIN = 1 * MiB;
constexpr size_t WS_WTOUT = 7 * MiB;
constexpr size_t WS_WTQ = 9 * MiB;
constexpr size_t WS_SKB = 13 * MiB;
constexpr size_t WS_UB = 14 * MiB;
constexpr size_t WS_VB = 46 * MiB;
constexpr size_t WS_PROJ = 78 * MiB;
constexpr size_t WS_X1 = 78 * MiB, WS_X1B = 142 * MiB;
constexpr size_t WS_XB = 174 * MiB;
constexpr size_t WS_QRY = 174 * MiB;
constexpr size_t WS_CAT = 206 * MiB;
constexpr size_t WS_ST = 238 * MiB;
constexpr size_t WS_PIDX = 238 * MiB, WS_PGATE = 246 * MiB;
constexpr size_t WS_ALR = 254 * MiB;
constexpr size_t WS_END = 255 * MiB + 512 * 1024;

constexpr int CW_BAR = 4096;

constexpr int LDS_BYTES = 147456;
constexpr int MISC_OFF = 140 * 1024;

__device__ __forceinline__ float bf2f(unsigned v) { return __uint_as_float(v << 16); }
__device__ __forceinline__ unsigned f2bf(float f) { unsigned u = __float_as_uint(f); return (u + 0x7fffu + ((u >> 16) & 1u)) >> 16; }
__device__ __forceinline__ unsigned pk2(float lo, float hi) { return f2bf(lo) | (f2bf(hi) << 16); }
__device__ __forceinline__ float wave_sum(float v) {
#pragma unroll
    for (int o = 1; o < 64; o <<= 1) v += __shfl_xor(v, o);
    return v;
}
__device__ __forceinline__ float logsig_neg(float z) {
    return -(fmaxf(z, 0.f) + log1pf(expf(-fabsf(z))));
}

#define XB_TMO      128
#define XB_XCNT(j)  (256  + 64 * (j))
#define XB_XSUB(j)  (1280 + 64 * (j))
#define XB_XGEN(j)  (2304 + 64 * (j))
#define XB_TOP      3328
#define XB_TOPGEN   3392
#define XCD_BAR_WORDS 3456
#define XB_SPIN_CAP (1u << 23)
__device__ __forceinline__ unsigned xb_ld(unsigned* p)              { return __hip_atomic_load(p, __ATOMIC_RELAXED, __HIP_MEMORY_SCOPE_AGENT); }
__device__ __forceinline__ unsigned xb_add(unsigned* p, unsigned v) { return __hip_atomic_fetch_add(p, v, __ATOMIC_RELAXED, __HIP_MEMORY_SCOPE_AGENT); }
__device__ __forceinline__ unsigned xb_xcc_id() { return (unsigned)__builtin_amdgcn_s_getreg((3 << 11) | 20) & 0xFu; }
#define XB_SPIN(cond, bar) do { unsigned _sp = 0; while (cond) { __builtin_amdgcn_s_sleep(1); \
    if ((++_sp & 255u) == 0u) { if (xb_ld(&(bar)[XB_TMO])) break; if (_sp > XB_SPIN_CAP) { atomicAdd(&(bar)[XB_TMO], 1u); break; } } } } while (0)
struct XcdBarrier { unsigned* bar; unsigned x; volatile LAS unsigned* st; };
__device__ __forceinline__ XcdBarrier xcd_barrier_post(unsigned* bar, volatile LAS unsigned* st) {
    XcdBarrier b; b.bar = bar; b.x = xb_xcc_id(); b.st = st;
    if (threadIdx.x == 0) (void)xb_add(&bar[XB_XCNT(b.x)], 1u);
    return b;
}
__device__ __forceinline__ void xcd_barrier_complete(unsigned* bar, unsigned x, unsigned& nloc, unsigned& nx) {
    const unsigned G = gridDim.x * gridDim.y * gridDim.z;
    unsigned sum, cnt, mine, sp = 0u;
    for (;;) {
        sum = 0u; cnt = 0u; mine = 0u;
#pragma unroll
        for (unsigned j = 0; j < 16; ++j) { const unsigned c = xb_ld(&bar[XB_XCNT(j)]); sum += c; cnt += (c > 0u) ? 1u : 0u; mine = (j == x) ? c : mine; }
        if (sum == G) break;
        __builtin_amdgcn_s_sleep(1);
        if ((++sp & 255u) == 0u) { if (xb_ld(&bar[XB_TMO])) break; if (sp > XB_SPIN_CAP) { atomicAdd(&bar[XB_TMO], 1u); break; } }
    }
    nloc = mine > 0u ? mine : 1u; nx = cnt > 0u ? cnt : 1u;
}
__device__ __forceinline__ void xcd_barrier(const XcdBarrier& b) {
    asm volatile("s_waitcnt vmcnt(0)" ::: "memory");
    __syncthreads();
    if (threadIdx.x == 0) {
        unsigned* bar = b.bar;
        __builtin_amdgcn_s_waitcnt(0);
        unsigned nloc = b.st[0], nx = b.st[1];
        if (nloc == 0u) { xcd_barrier_complete(bar, b.x, nloc, nx); b.st[0] = nloc; b.st[1] = nx; }
        const unsigned old = xb_add(&bar[XB_XSUB(b.x)], 1u);
        const unsigned gen = old / nloc;
        if (old + 1u == (gen + 1u) * nloc) {
            __builtin_amdgcn_fence(__ATOMIC_RELEASE, "agent");
            asm volatile("s_waitcnt vmcnt(0)" ::: "memory");
            const unsigned og = xb_add(&bar[XB_TOP], 1u);
            const unsigned tg = og / nx;
            if (og + 1u == (tg + 1u) * nx) xb_add(&bar[XB_TOPGEN], 1u);
            else XB_SPIN(xb_ld(&bar[XB_TOPGEN]) == tg, bar);
            __builtin_amdgcn_fence(__ATOMIC_ACQUIRE, "agent");
            xb_add(&bar[XB_XGEN(b.x)], 1u);
            asm volatile("s_waitcnt vmcnt(0)" ::: "memory");
        } else {
            XB_SPIN(xb_ld(&bar[XB_XGEN(b.x)]) == gen, bar);
            __builtin_amdgcn_fence(__ATOMIC_ACQUIRE, "agent");
            asm volatile("s_waitcnt vmcnt(0)" ::: "memory");
        }
    }
    __syncthreads();
}

struct Frame {
    unsigned char* lds;
    int tid, lane, wave, vcu, G;
    const float *x, *w_in, *w_gate, *b_gate, *gla_g, *sb_g, *w_out, *ln1_g, *ln1_b, *w_q, *sub_keys, *pu, *pv, *ln2_g, *ln2_b;
    float* out;
    unsigned char* ws;
};
#define WSP(type, off) ((type*)(F.ws + (off)))

__device__ __forceinline__ void p0_transpose_item(const float* W, int K, int ldw, int c0, int ncols, bf16* WT, int row_off, float* scr, int item, int lane) {
    const int nblk = ncols / 32, kb = item / nblk, nb = item % nblk, k0 = 64 * kb, n0 = 32 * nb;
#pragma unroll 8
    for (int i = 0; i < 32; ++i) { const int kk = 2 * i + (lane >> 5); scr[kk * 33 + (lane & 31)] = W[(size_t)(k0 + kk) * ldw + c0 + n0 + (lane & 31)]; }
    asm volatile("s_waitcnt lgkmcnt(0)" ::: "memory");
    const int c = lane & 7;
#pragma unroll
    for (int j = 0; j < 4; ++j) { const int n = (lane >> 3) + 8 * j; const float* s = scr + (8 * c) * 33 + n;
        v4u o; o.x = pk2(s[0 * 33], s[1 * 33]); o.y = pk2(s[2 * 33], s[3 * 33]); o.z = pk2(s[4 * 33], s[5 * 33]); o.w = pk2(s[6 * 33], s[7 * 33]);
        *(v4u*)(WT + (size_t)(row_off + n0 + n) * K + k0 + 8 * c) = o; }
    asm volatile("s_waitcnt lgkmcnt(0)" ::: "memory");
}
__device__ __forceinline__ void cvt_f32_bf16_bulk(Frame& F, const float* src, bf16* dst, size_t n8) {
    const size_t gt = (size_t)F.vcu * NTHR + F.tid, NT = (size_t)F.G * NTHR;
    for (size_t i = gt; i < n8; i += NT) {
        const f32x4 a = *(const f32x4*)(src + i * 8), b = *(const f32x4*)(src + i * 8 + 4);
        v4u o; o.x = pk2(a.x, a.y); o.y = pk2(a.z, a.w); o.z = pk2(b.x, b.y); o.w = pk2(b.z, b.w);
        *(v4u*)(dst + i * 8) = o;
    }
}
__device__ __forceinline__ void ph0_prologue(Frame& F) {
    float* wa = (float*)F.lds;
    float* scr = (float*)(F.lds + 65536 + F.wave * 8448);
    const int gw = F.vcu * NWAVES + F.wave, NGW = F.G * NWAVES;
    for (int idx = F.tid; idx < 16384; idx += NTHR) { const int k = idx >> 4, r = idx & 15; wa[r * 1024 + k] = F.w_in[(size_t)k * INW + A_COL + r]; }
    constexpr int I_IN1 = 16 * 48, I_IN2 = 16 * 48, I_OUT = 16 * 32, I_Q = 16 * 64, NITEMS = I_IN1 + I_IN2 + I_OUT + I_Q;
    for (int it = gw; it < NITEMS; it += NGW) {
        int r = it;
        if (r < I_IN1) { p0_transpose_item(F.w_in, 1024, INW, 0, 1536, WSP(bf16, WS_WTIN), 0, scr, r, F.lane); continue; } r -= I_IN1;
        if (r < I_IN2) { p0_transpose_item(F.w_in, 1024, INW, 1552, 1536, WSP(bf16, WS_WTIN), 1536, scr, r, F.lane); continue; } r -= I_IN2;
        if (r < I_OUT) { p0_transpose_item(F.w_out, 1024, 1024, 0, 1024, WSP(bf16, WS_WTOUT), 0, scr, r, F.lane); continue; } r -= I_OUT;
        p0_transpose_item(F.w_q, 1024, 2048, 0, 2048, WSP(bf16, WS_WTQ), 0, scr, r, F.lane);
    }
    cvt_f32_bf16_bulk(F, F.sub_keys, WSP(bf16, WS_SKB), (size_t)8 * 2 * 128 * 128 / 8);
    cvt_f32_bf16_bulk(F, F.pu, WSP(bf16, WS_UB), (size_t)16384 * 1024 / 8);
    cvt_f32_bf16_bulk(F, F.pv, WSP(bf16, WS_VB), (size_t)16384 * 1024 / 8);
    __syncthreads();
    bf16* xb = WSP(bf16, WS_XB); float* alr = WSP(float, WS_ALR);
    for (int m = gw; m < T; m += NGW) {
        const float* xr = F.x + (size_t)m * DM;
        f32x4 xv[4];
#pragma unroll
        for (int i = 0; i < 4; ++i) { xv[i] = *(const f32x4*)(xr + 256 * i + 4 * F.lane);
            v2u o; o.x = pk2(xv[i].x, xv[i].y); o.y = pk2(xv[i].z, xv[i].w); *(v2u*)(xb + (size_t)m * DM + 256 * i + 4 * F.lane) = o; }
        float mine = 0.f;
#pragma unroll 2
        for (int r = 0; r < 16; ++r) {
            float a = 0.f;
#pragma unroll
            for (int i = 0; i < 4; ++i) { const f32x4 w = *(const f32x4*)(wa + r * 1024 + 256 * i + 4 * F.lane); a += xv[i].x * w.x + xv[i].y * w.y + xv[i].z * w.z + xv[i].w * w.w; }
            a = wave_sum(a);
            mine = (F.lane == r) ? a : mine;
        }
        if (F.lane < 16) alr[(size_t)m * 16 + F.lane] = mine;
    }
}

struct EpiBf16Store { bf16* C; int ldc;
    __device__ __forceinline__ void operator()(int row, int col, const float (&acc)[8][4]) const {
#pragma unroll
        for (int i = 0; i < 8; ++i) { v2u o; o.x = pk2(acc[i][0], acc[i][1]); o.y = pk2(acc[i][2], acc[i][3]); *(v2u*)(C + (size_t)(row + i) * ldc + col) = o; } } };
struct EpiF32Store { float* C; int ldc;
    __device__ __forceinline__ void operator()(int row, int col, const float (&acc)[8][4]) const {
#pragma unroll
        for (int i = 0; i < 8; ++i) *(f32x4*)(C + (size_t)(row + i) * ldc + col) = (f32x4){acc[i][0], acc[i][1], acc[i][2], acc[i][3]}; } };
template <class Epi>
__device__ __forceinline__ void naive_gemm(Frame& F, const bf16* A, const bf16* Bt, int M, int N, int K, const Epi& epi) {
    float* As = (float*)F.lds; float* Bs = As + 32 * 132;
    const int tid = F.tid, tm = tid >> 5, tn = tid & 31, lr = tid >> 2, lk = (tid & 3) * 8;
    const int nN = N / 128, nU = (M / 128) * nN;
    for (int u = F.vcu; u < nU; u += F.G) {
        const int pm = u / nN, pn = u % nN;
        float acc[8][4];
#pragma unroll
        for (int i = 0; i < 8; ++i)
#pragma unroll
            for (int j = 0; j < 4; ++j) acc[i][j] = 0.f;
        const bf16* ap = A + (size_t)(pm * 128 + lr) * K + lk; const bf16* bp = Bt + (size_t)(pn * 128 + lr) * K + lk;
        for (int k0 = 0; k0 < K; k0 += 32) {
            const v4u av = *(const v4u*)(ap + k0), bv = *(const v4u*)(bp + k0);
            __syncthreads();
#pragma unroll
            for (int j = 0; j < 4; ++j) {
                As[(lk + 2 * j) * 132 + lr] = __uint_as_float(av[j] << 16); As[(lk + 2 * j + 1) * 132 + lr] = __uint_as_float(av[j] & 0xffff0000u);
                Bs[(lk + 2 * j) * 132 + lr] = __uint_as_float(bv[j] << 16); Bs[(lk + 2 * j + 1) * 132 + lr] = __uint_as_float(bv[j] & 0xffff0000u); }
            __syncthreads();
#pragma unroll 4
            for (int k = 0; k < 32; ++k) {
                const f32x4 a0 = *(const f32x4*)(As + k * 132 + tm * 8), a1 = *(const f32x4*)(As + k * 132 + tm * 8 + 4), b = *(const f32x4*)(Bs + k * 132 + tn * 4);
                const float a[8] = {a0.x, a0.y, a0.z, a0.w, a1.x, a1.y, a1.z, a1.w}; const float bb[4] = {b.x, b.y, b.z, b.w};
#pragma unroll
                for (int i = 0; i < 8; ++i)
#pragma unroll
                    for (int j = 0; j < 4; ++j) acc[i][j] += a[i] * bb[j];
            }
        }
        epi(pm * 128 + tm * 8, pn * 128 + tn * 4, acc);
    }
    __syncthreads();
}

__device__ __forceinline__ void ph2_gla_naive(Frame& F) {
    if (F.vcu >= 8) return;
    const int bh = F.vcu, b = bh >> 2, h = bh & 3, tid = F.tid;
    float* qs = (float*)F.lds; float* ks = qs + 1024; float* as = ks + 1024; float* os = as + 1024;
    const bf16* proj = WSP(bf16, WS_PROJ); const float* alr = WSP(float, WS_ALR); bf16* cat = WSP(bf16, WS_CAT);
    float S[64];
#pragma unroll
    for (int c = 0; c < 64; ++c) S[c] = 0.f;
    for (int t0 = 0; t0 < SEQ; t0 += 16) {
        __syncthreads();
        for (int i = tid; i < 1024; i += NTHR) {
            const int tt = i >> 6, c = i & 63; const size_t row = (size_t)b * SEQ + t0 + tt;
            qs[i] = bf2f(proj[row * NPJ + C_QG + h * 64 + c]) * 0.125f;
            ks[i] = bf2f(proj[row * NPJ + C_KG + h * 64 + c]);
            float s = F.b_gate[h * 64 + c];
#pragma unroll
            for (int r = 0; r < 16; ++r) s += alr[row * 16 + r] * F.w_gate[r * 256 + h * 64 + c];
            const float la = -(fmaxf(-s, 0.f) + log1pf(expf(-fabsf(s)))) * (1.0f / 16.0f);
            as[i] = expf(la);
        }
        __syncthreads();
        if (tid < 128) {
            for (int tt = 0; tt < 16; ++tt) {
                const size_t row = (size_t)b * SEQ + t0 + tt;
                const float v = bf2f(proj[row * NPJ + C_VG + h * 128 + tid]); float o = 0.f;
#pragma unroll
                for (int c = 0; c < 64; ++c) { S[c] = S[c] * as[tt * 64 + c] + ks[tt * 64 + c] * v; o += qs[tt * 64 + c] * S[c]; }
                os[tt * 128 + tid] = o;
            }
        }
        __syncthreads();
#pragma unroll
        for (int j = 0; j < 2; ++j) {
            const int tt = F.wave * 2 + j; const size_t row = (size_t)b * SEQ + t0 + tt;
            const float o0 = os[tt * 128 + F.lane], o1 = os[tt * 128 + 64 + F.lane];
            const float ss = wave_sum(o0 * o0 + o1 * o1); const float r = rsqrtf(ss * (1.0f / 128.0f) + EPS);
            const float g0 = bf2f(proj[row * NPJ + C_GG + h * 128 + F.lane]), g1 = bf2f(proj[row * NPJ + C_GG + h * 128 + 64 + F.lane]);
            const float y0 = o0 * r * F.gla_g[h * 128 + F.lane] * (g0 / (1.f + expf(-g0)));
            const float y1 = o1 * r * F.gla_g[h * 128 + 64 + F.lane] * (g1 / (1.f + expf(-g1)));
            cat[row * DM + h * 128 + F.lane] = (bf16)f2bf(y0); cat[row * DM + h * 128 + 64 + F.lane] = (bf16)f2bf(y1);
        }
    }
    __syncthreads();
}
__device__ __forceinline__ void ph2_sb_naive(Frame& F) {
    const bf16* proj = WSP(bf16, WS_PROJ); bf16* cat = WSP(bf16, WS_CAT);
    float* Ks = (float*)F.lds; float* Vs = Ks + 32 * 64;
    const int tid = F.tid;
    for (int u = F.vcu; u < 256; u += F.G) {
        const int bh = u >> 4, qb = u & 15, b = bh >> 3, h = bh & 7, t = qb * 512 + tid; const size_t row = (size_t)b * SEQ + t;
        float q[64], o[64];
#pragma unroll
        for (int i = 0; i < 8; ++i) { const v4u w = *(const v4u*)(proj + row * NPJ + C_QS + h * 64 + 8 * i);
#pragma unroll
            for (int j = 0; j < 4; ++j) { q[8 * i + 2 * j] = __uint_as_float(w[j] << 16) * 0.125f; q[8 * i + 2 * j + 1] = __uint_as_float(w[j] & 0xffff0000u) * 0.125f; } }
#pragma unroll
        for (int d = 0; d < 64; ++d) o[d] = 0.f;
        float tail = 0.f;
        for (int kt = (qb * 512 + 511) / 32; kt >= 0; --kt) {
            __syncthreads();
            { const int key = tid >> 4, d4 = (tid & 15) * 4; const size_t krow = (size_t)b * SEQ + kt * 32 + key;
              const v2u kk = *(const v2u*)(proj + krow * NPJ + C_KS + h * 64 + d4), vv = *(const v2u*)(proj + krow * NPJ + C_VS + h * 64 + d4);
              *(f32x4*)(Ks + key * 64 + d4) = (f32x4){__uint_as_float(kk.x << 16), __uint_as_float(kk.x & 0xffff0000u), __uint_as_float(kk.y << 16), __uint_as_float(kk.y & 0xffff0000u)};
              *(f32x4*)(Vs + key * 64 + d4) = (f32x4){__uint_as_float(vv.x << 16), __uint_as_float(vv.x & 0xffff0000u), __uint_as_float(vv.y << 16), __uint_as_float(vv.y & 0xffff0000u)}; }
            __syncthreads();
            for (int j = 31; j >= 0; --j) {
                const int s = kt * 32 + j;
                float z = 0.f;
#pragma unroll
                for (int d4 = 0; d4 < 16; ++d4) { const f32x4 k4 = *(const f32x4*)(Ks + j * 64 + 4 * d4); z += q[4 * d4] * k4.x + q[4 * d4 + 1] * k4.y + q[4 * d4 + 2] * k4.z + q[4 * d4 + 3] * k4.w; }
                const bool valid = s < t;
                const float lnb = logsig_neg(z);
                const float w = valid ? expf(z + lnb + tail) : 0.f;
                tail += valid ? lnb : 0.f;
#pragma unroll
                for (int d4 = 0; d4 < 16; ++d4) { const f32x4 v4 = *(const f32x4*)(Vs + j * 64 + 4 * d4); o[4 * d4] += w * v4.x; o[4 * d4 + 1] += w * v4.y; o[4 * d4 + 2] += w * v4.z; o[4 * d4 + 3] += w * v4.w; }
            }
        }
        float ss = 0.f;
#pragma unroll
        for (int d = 0; d < 64; ++d) ss += o[d] * o[d];
        const float r = rsqrtf(ss * (1.0f / 64.0f) + EPS);
#pragma unroll
        for (int i = 0; i < 8; ++i) { v4u w;
#pragma unroll
            for (int j = 0; j < 4; ++j) w[j] = pk2(o[8 * i + 2 * j] * r * F.sb_g[h * 64 + 8 * i + 2 * j], o[8 * i + 2 * j + 1] * r * F.sb_g[h * 64 + 8 * i + 2 * j + 1]);
            *(v4u*)(cat + row * DM + 512 + h * 64 + 8 * i) = w; }
    }
    __syncthreads();
}

__device__ __forceinline__ void ph4_ln1(Frame& F) {
    const int gw = F.vcu * NWAVES + F.wave, NGW = F.G * NWAVES;
    float* x1 = WSP(float, WS_X1); bf16* x1b = WSP(bf16, WS_X1B);
    for (int m = gw; m < T; m += NGW) {
        f32x4 y[4]; float s = 0.f;
#pragma unroll
        for (int i = 0; i < 4; ++i) { const size_t o = (size_t)m * DM + 256 * i + 4 * F.lane; y[i] = *(const f32x4*)(F.x + o) * ALPHA + *(const f32x4*)(F.out + o); s += (y[i].x + y[i].y) + (y[i].z + y[i].w); }
        const float mean = wave_sum(s) * (1.0f / DM); float q = 0.f;
#pragma unroll
        for (int i = 0; i < 4; ++i) { y[i] = y[i] - mean; q += (y[i].x * y[i].x + y[i].y * y[i].y) + (y[i].z * y[i].z + y[i].w * y[i].w); }
        const float rstd = rsqrtf(wave_sum(q) * (1.0f / DM) + EPS);
#pragma unroll
        for (int i = 0; i < 4; ++i) { const int c = 256 * i + 4 * F.lane; const size_t o = (size_t)m * DM + c;
            const f32x4 r = y[i] * rstd * *(const f32x4*)(F.ln1_g + c) + *(const f32x4*)(F.ln1_b + c);
            *(f32x4*)(x1 + o) = r; v2u w; w.x = pk2(r.x, r.y); w.y = pk2(r.z, r.w); *(v2u*)(x1b + o) = w; }
    }
}

#define TOPK_INSERT(cv, ci, VAL, IDX) do { float _cv = (cv); int _ci = (ci); \
    _Pragma("unroll") for (int _j = 0; _j < 16; ++_j) { const bool _g = _cv > VAL[_j]; const float _tv = VAL[_j]; const int _ti = IDX[_j]; \
        VAL[_j] = _g ? _cv : _tv; IDX[_j] = _g ? _ci : _ti; _cv = _g ? _tv : _cv; _ci = _g ? _ti : _ci; } } while (0)
__device__ __forceinline__ void ph6_topk_naive(Frame& F) {
    const bf16* qry = WSP(bf16, WS_QRY); const bf16* skb = WSP(bf16, WS_SKB);
    int* pidx = WSP(int, WS_PIDX); float* pgate = WSP(float, WS_PGATE);
    float* sk = (float*)F.lds;
    const int tid = F.tid;
    for (int u = F.vcu; u < 256; u += F.G) {
        const int h = u >> 5, tb = u & 31, t = tb * 512 + tid;
        float sv[2][16]; int si[2][16];
#pragma unroll
        for (int p = 0; p < 2; ++p) {
            __syncthreads();
            for (int i = tid; i < 128 * 128 / 2; i += NTHR) { const unsigned w = *(const unsigned*)(skb + (size_t)(h * 2 + p) * 16384 + 2 * i); sk[2 * i] = __uint_as_float(w << 16); sk[2 * i + 1] = __uint_as_float(w & 0xffff0000u); }
            __syncthreads();
            unsigned qp[64];
#pragma unroll
            for (int i = 0; i < 16; ++i) { const v4u w = *(const v4u*)(qry + (size_t)t * 2048 + h * 256 + p * 128 + 8 * i); qp[4 * i] = w.x; qp[4 * i + 1] = w.y; qp[4 * i + 2] = w.z; qp[4 * i + 3] = w.w; }
#pragma unroll
            for (int j = 0; j < 16; ++j) { sv[p][j] = -INFINITY; si[p][j] = 0; }
            for (int n = 0; n < 128; ++n) {
                float s = 0.f;
#pragma unroll
                for (int c4 = 0; c4 < 32; ++c4) { const f32x4 k4 = *(const f32x4*)(sk + n * 128 + 4 * c4);
                    s += __uint_as_float(qp[2 * c4] << 16) * k4.x + __uint_as_float(qp[2 * c4] & 0xffff0000u) * k4.y + __uint_as_float(qp[2 * c4 + 1] << 16) * k4.z + __uint_as_float(qp[2 * c4 + 1] & 0xffff0000u) * k4.w; }
                TOPK_INSERT(s, n, sv[p], si[p]);
            }
        }
        float bv[16]; int bi[16];
#pragma unroll
        for (int j = 0; j < 16; ++j) { bv[j] = -INFINITY; bi[j] = 0; }
#pragma unroll
        for (int i = 0; i < 16; ++i)
#pragma unroll
            for (int j = 0; j < 16; ++j) TOPK_INSERT(sv[0][i] + sv[1][j], si[0][i] * 128 + si[1][j], bv, bi);
        float den = 0.f; float e[16];
#pragma unroll
        for (int j = 0; j < 16; ++j) { e[j] = expf(bv[j] - bv[0]); den += e[j]; }
        const float inv = 1.0f / den;
#pragma unroll
        for (int j4 = 0; j4 < 4; ++j4) {
            *(f32x4*)(pgate + (size_t)t * 128 + h * 16 + 4 * j4) = (f32x4){e[4 * j4] * inv, e[4 * j4 + 1] * inv, e[4 * j4 + 2] * inv, e[4 * j4 + 3] * inv};
            *(v4u*)(pidx + (size_t)t * 128 + h * 16 + 4 * j4) = (v4u){(unsigned)bi[4 * j4], (unsigned)bi[4 * j4 + 1], (unsigned)bi[4 * j4 + 2], (unsigned)bi[4 * j4 + 3]};
        }
    }
    __syncthreads();
}

__device__ __forceinline__ void ph7_peer_naive(Frame& F) {
    const int gw = F.vcu * NWAVES + F.wave, NGW = F.G * NWAVES;
    const float* x1 = WSP(float, WS_X1); const int* pidx = WSP(int, WS_PIDX); const float* pgate = WSP(float, WS_PGATE);
    for (int m = gw; m < T; m += NGW) {
        f32x4 xv[4], acc[4];
#pragma unroll
        for (int i = 0; i < 4; ++i) { xv[i] = *(const f32x4*)(x1 + (size_t)m * DM + 256 * i + 4 * F.lane); acc[i] = (f32x4){0.f, 0.f, 0.f, 0.f}; }
        for (int k = 0; k < 128; ++k) {
            const int e = __builtin_amdgcn_readfirstlane(pidx[(size_t)m * 128 + k]); const float g = pgate[(size_t)m * 128 + k];
            const float* ur = F.pu + (size_t)e * DM; const float* vr = F.pv + (size_t)e * DM;
            float p = 0.f;
#pragma unroll
            for (int i = 0; i < 4; ++i) { const f32x4 uu = *(const f32x4*)(ur + 256 * i + 4 * F.lane); p += (uu.x * xv[i].x + uu.y * xv[i].y) + (uu.z * xv[i].z + uu.w * xv[i].w); }
            p = wave_sum(p);
            const float w = g * 0.5f * p * (1.0f + erff(p * 0.70710678118654752f));
#pragma unroll
            for (int i = 0; i < 4; ++i) acc[i] += *(const f32x4*)(vr + 256 * i + 4 * F.lane) * w;
        }
        float s = 0.f;
#pragma unroll
        for (int i = 0; i < 4; ++i) { acc[i] = xv[i] * ALPHA + acc[i]; s += (acc[i].x + acc[i].y) + (acc[i].z + acc[i].w); }
        const float mean = wave_sum(s) * (1.0f / DM); float q = 0.f;
#pragma unroll
        for (int i = 0; i < 4; ++i) { acc[i] = acc[i] - mean; q += (acc[i].x * acc[i].x + acc[i].y * acc[i].y) + (acc[i].z * acc[i].z + acc[i].w * acc[i].w); }
        const float rstd = rsqrtf(wave_sum(q) * (1.0f / DM) + EPS);
#pragma unroll
        for (int i = 0; i < 4; ++i) { const int c = 256 * i + 4 * F.lane;
            *(f32x4*)(F.out + (size_t)m * DM + c) = acc[i] * rstd * *(const f32x4*)(F.ln2_g + c) + *(const f32x4*)(F.ln2_b + c); }
    }
}

struct Args { const float* in[15]; float* out; unsigned char* ws; int ph_lo, ph_hi, li, pad; };
__global__ void __launch_bounds__(NTHR, 2) mk_fwd(Args args) {
    extern __shared__ __attribute__((aligned(16))) unsigned char lds[];
    Frame F;
    F.lds = lds; F.tid = threadIdx.x; F.lane = F.tid & 63; F.wave = __builtin_amdgcn_readfirstlane(F.tid >> 6);
    F.G = gridDim.x; { const int bx = blockIdx.x; F.vcu = (F.G % 8 == 0) ? (bx % 8) * (F.G / 8) + bx / 8 : bx; }
    F.x = args.in[0]; F.w_in = args.in[1]; F.w_gate = args.in[2]; F.b_gate = args.in[3]; F.gla_g = args.in[4]; F.sb_g = args.in[5]; F.w_out = args.in[6];
    F.ln1_g = args.in[7]; F.ln1_b = args.in[8]; F.w_q = args.in[9]; F.sub_keys = args.in[10]; F.pu = args.in[11]; F.pv = args.in[12]; F.ln2_g = args.in[13]; F.ln2_b = args.in[14];
    F.out = args.out; F.ws = args.ws;
    volatile LAS unsigned* MISC = (volatile LAS unsigned*)((LAS unsigned char*)lds + MISC_OFF);
    if (F.tid < 32) MISC[F.tid] = 0u;
    __syncthreads();
    unsigned* barw = (unsigned*)(F.ws + WS_CTL) + CW_BAR + args.li * XCD_BAR_WORDS;
    XcdBarrier bar; bar.bar = barw; bar.x = 0; bar.st = nullptr;
    const int lo = args.ph_lo, hi = args.ph_hi;
    if (hi - lo > 1) bar = xcd_barrier_post(barw, MISC + 8);
#ifndef PH_MASK
#define PH_MASK 0xff
#endif
#define IN(k) (((PH_MASK >> (k)) & 1) && lo <= (k) && (k) < hi)
#define SEAM(k) do { if (IN(k) && IN((k) + 1)) xcd_barrier(bar); } while (0)
    if (IN(0)) { ph0_prologue(F); } SEAM(0);
    if (IN(1)) { naive_gemm(F, WSP(bf16, WS_XB), WSP(bf16, WS_WTIN), T, NPJ, DM, EpiBf16Store{WSP(bf16, WS_PROJ), NPJ}); } SEAM(1);
    if (IN(2)) { ph2_gla_naive(F); ph2_sb_naive(F); } SEAM(2);
    if (IN(3)) { naive_gemm(F, WSP(bf16, WS_CAT), WSP(bf16, WS_WTOUT), T, DM, DM, EpiF32Store{F.out, DM}); } SEAM(3);
    if (IN(4)) { ph4_ln1(F); } SEAM(4);
    if (IN(5)) { naive_gemm(F, WSP(bf16, WS_X1B), WSP(bf16, WS_WTQ), T, 2048, DM, EpiBf16Store{WSP(bf16, WS_QRY), 2048}); } SEAM(5);
    if (IN(6)) { ph6_topk_naive(F); } SEAM(6);
    if (IN(7)) { ph7_peer_naive(F); }
#undef IN
#undef SEAM
}

extern "C" void kernel_launch(void* const* d_in, const int* in_sizes, int n_in, void* d_out, int out_size, void* d_ws, size_t ws_size, hipStream_t stream) {
    static int grid = 0;
    if (grid == 0) {
        if (n_in != 15 || in_sizes[0] != T * DM || out_size != T * DM || ws_size < WS_END) {
            fprintf(stderr, "kernel_launch: unexpected problem: n_in %d in0 %d out %d ws %zu (need %zu)\n", n_in, n_in > 0 ? in_sizes[0] : -1, out_size, ws_size, (size_t)WS_END); grid = -1; return; }
        int dev = 0, cus = 0;
        if (hipGetDevice(&dev) != hipSuccess || hipDeviceGetAttribute(&cus, hipDeviceAttributeMultiprocessorCount, dev) != hipSuccess) { grid = -1; return; }
        if (hipFuncSetAttribute((const void*)mk_fwd, hipFuncAttributeMaxDynamicSharedMemorySize, LDS_BYTES) != hipSuccess) { fprintf(stderr, "kernel_launch: hipFuncSetAttribute failed\n"); grid = -1; return; }
        (void)hipGetLastError();
        grid = cus;
    }
    if (grid < 0) return;
    if (hipMemsetAsync((char*)d_ws + WS_CTL, 0, CTL_ZERO_BYTES, stream) != hipSuccess) { fprintf(stderr, "kernel_launch: memset failed\n"); return; }
    Args a{};
    for (int i = 0; i < 15; ++i) a.in[i] = (const float*)d_in[i];
    a.out = (float*)d_out; a.ws = (unsigned char*)d_ws;
    constexpr int NL = MK_N_LAUNCHES;
    for (int li = 0; li < NL; ++li) {
        a.ph_lo = (NL == 1) ? 0 : li; a.ph_hi = (NL == 1) ? NPHASE : li + 1; a.li = li;
        hipLaunchKernelGGL(mk_fwd, dim3(grid), dim3(NTHR), LDS_BYTES, stream, a);
        const hipError_t le = hipPeekAtLastError();
        if (le != hipSuccess) { fprintf(stderr, "kernel_launch: launch %d failed: %s\n", li, hipGetErrorName(le)); break; }
    }
}
```

```cpp
#include <hip/hip_runtime.h>
#include <cstdio>
#include <cstdint>

#ifndef MK_N_LAUNCHES
#define MK_N_LAUNCHES 1
#endif

#define GAS __attribute__((address_space(1)))
#define LAS __attribute__((address_space(3)))
typedef unsigned short bf16;
typedef unsigned v4u __attribute__((ext_vector_type(4)));
typedef unsigned v2u __attribute__((ext_vector_type(2)));
typedef float f32x4 __attribute__((ext_vector_type(4)));
typedef float f32x2 __attribute__((ext_vector_type(2)));

constexpr int BATCH = 2, SEQ = 8192, DM = 1024, T = BATCH * SEQ;
constexpr int INW = 3088, NPJ = 3072;
constexpr int C_QG = 0, C_KG = 256, C_VG = 512, C_GG = 1024, C_QS = 1536, C_KS = 2048, C_VS = 2560;
constexpr int A_COL = 1536;
constexpr float ALPHA = 1.18920711500272f;
constexpr float EPS = 1e-5f;
constexpr int NWAVES = 8, NTHR = 512;
constexpr int NPHASE = 10;
constexpr float SB_EXIT_NAT = 30.0f;

constexpr size_t MiB = 1u << 20;
constexpr size_t WS_CTL = 0, CTL_ZERO_BYTES = 1 * MiB;
constexpr size_t WS_WTIN = 1 * MiB;
constexpr size_t WS_WTOUT = 7 * MiB;
constexpr size_t WS_WTQ = 9 * MiB;
constexpr size_t WS_SKB = 13 * MiB;
constexpr size_t WS_UB = 14 * MiB;
constexpr size_t WS_VB = 46 * MiB;
constexpr size_t WS_PROJ = 78 * MiB;
constexpr size_t WS_X1 = 78 * MiB, WS_X1B = 142 * MiB;
constexpr size_t WS_XB = 174 * MiB;
constexpr size_t WS_QRY = 174 * MiB;
constexpr size_t WS_CAT = 206 * MiB;
constexpr size_t WS_ST = 238 * MiB;
constexpr size_t WS_PIDX = 238 * MiB, WS_PGATE = 246 * MiB;
constexpr size_t WS_ALPHA = 238 * MiB;
constexpr size_t WS_SLOC = 174 * MiB;
constexpr size_t WS_DEC = 254 * MiB;
constexpr size_t WS_END = 255 * MiB + 512 * 1024;

constexpr int CW_BAR = 4096;

constexpr int LDS_BYTES = 147456;
constexpr int MISC_OFF = 140 * 1024;

__device__ __forceinline__ float bf2f(unsigned v) { return __uint_as_float(v << 16); }
__device__ __forceinline__ unsigned f2bf(float f) { unsigned u = __float_as_uint(f); return (u + 0x7fffu + ((u >> 16) & 1u)) >> 16; }
__device__ __forceinline__ unsigned pk2(float lo, float hi) { return f2bf(lo) | (f2bf(hi) << 16); }
__device__ __forceinline__ float wave_sum(float v) {
#pragma unroll
    for (int o = 1; o < 64; o <<= 1) v += __shfl_xor(v, o);
    return v;
}
__device__ __forceinline__ float logsig_neg(float z) {
    return -(fmaxf(z, 0.f) + log1pf(expf(-fabsf(z))));
}

#define XB_TMO      128
#define XB_XCNT(j)  (256  + 64 * (j))
#define XB_XSUB(j)  (1280 + 64 * (j))
#define XB_XGEN(j)  (2304 + 64 * (j))
#define XB_TOP      3328
#define XB_TOPGEN   3392
#define XCD_BAR_WORDS 3456
#define XB_SPIN_CAP (1u << 23)
__device__ __forceinline__ unsigned xb_ld(unsigned* p)              { return __hip_atomic_load(p, __ATOMIC_RELAXED, __HIP_MEMORY_SCOPE_AGENT); }
__device__ __forceinline__ unsigned xb_add(unsigned* p, unsigned v) { return __hip_atomic_fetch_add(p, v, __ATOMIC_RELAXED, __HIP_MEMORY_SCOPE_AGENT); }
__device__ __forceinline__ unsigned xb_xcc_id() { return (unsigned)__builtin_amdgcn_s_getreg((3 << 11) | 20) & 0xFu; }
#define XB_SPIN(cond, bar) do { unsigned _sp = 0; while (cond) { __builtin_amdgcn_s_sleep(1); \
    if ((++_sp & 255u) == 0u) { if (xb_ld(&(bar)[XB_TMO])) break; if (_sp > XB_SPIN_CAP) { atomicAdd(&(bar)[XB_TMO], 1u); break; } } } } while (0)
struct XcdBarrier { unsigned* bar; unsigned x; volatile LAS unsigned* st; };
__device__ __forceinline__ XcdBarrier xcd_barrier_post(unsigned* bar, volatile LAS unsigned* st) {
    XcdBarrier b; b.bar = bar; b.x = xb_xcc_id(); b.st = st;
    if (threadIdx.x == 0) (void)xb_add(&bar[XB_XCNT(b.x)], 1u);
    return b;
}
__device__ __forceinline__ void xcd_barrier_complete(unsigned* bar, unsigned x, unsigned& nloc, unsigned& nx) {
    const unsigned G = gridDim.x * gridDim.y * gridDim.z;
    unsigned sum, cnt, mine, sp = 0u;
    for (;;) {
        sum = 0u; cnt = 0u; mine = 0u;
#pragma unroll
        for (unsigned j = 0; j < 16; ++j) { const unsigned c = xb_ld(&bar[XB_XCNT(j)]); sum += c; cnt += (c > 0u) ? 1u : 0u; mine = (j == x) ? c : mine; }
        if (sum == G) break;
        __builtin_amdgcn_s_sleep(1);
        if ((++sp & 255u) == 0u) { if (xb_ld(&bar[XB_TMO])) break; if (sp > XB_SPIN_CAP) { atomicAdd(&bar[XB_TMO], 1u); break; } }
    }
    nloc = mine > 0u ? mine : 1u; nx = cnt > 0u ? cnt : 1u;
}
__device__ __forceinline__ void xcd_barrier(const XcdBarrier& b) {
    asm volatile("s_waitcnt vmcnt(0)" ::: "memory");
    __syncthreads();
    if (threadIdx.x == 0) {
        unsigned* bar = b.bar;
        __builtin_amdgcn_s_waitcnt(0);
        unsigned nloc = b.st[0], nx = b.st[1];
        if (nloc == 0u) { xcd_barrier_complete(bar, b.x, nloc, nx); b.st[0] = nloc; b.st[1] = nx; }
        const unsigned old = xb_add(&bar[XB_XSUB(b.x)], 1u);
        const unsigned gen = old / nloc;
        if (old + 1u == (gen + 1u) * nloc) {
            __builtin_amdgcn_fence(__ATOMIC_RELEASE, "agent");
            asm volatile("s_waitcnt vmcnt(0)" ::: "memory");
            const unsigned og = xb_add(&bar[XB_TOP], 1u);
            const unsigned tg = og / nx;
            if (og + 1u == (tg + 1u) * nx) xb_add(&bar[XB_TOPGEN], 1u);
            else XB_SPIN(xb_ld(&bar[XB_TOPGEN]) == tg, bar);
            __builtin_amdgcn_fence(__ATOMIC_ACQUIRE, "agent");
            xb_add(&bar[XB_XGEN(b.x)], 1u);
            asm volatile("s_waitcnt vmcnt(0)" ::: "memory");
        } else {
            XB_SPIN(xb_ld(&bar[XB_XGEN(b.x)]) == gen, bar);
            __builtin_amdgcn_fence(__ATOMIC_ACQUIRE, "agent");
            asm volatile("s_waitcnt vmcnt(0)" ::: "memory");
        }
    }
    __syncthreads();
}

namespace pg8 {
#define PG8_LAS __attribute__((address_space(3)))
typedef unsigned short bf16_t;
typedef short bf16x8 __attribute__((ext_vector_type(8)));
typedef float f32x4 __attribute__((ext_vector_type(4)));
typedef unsigned u32x4 __attribute__((ext_vector_type(4)));
constexpr int BM = 256, BK = 64, HALF = 128, HTB = HALF * BK * 2  , STAGE_BYTES = 8 * HTB, NXCD = 8, WGM = 8;

__host__ __device__ __forceinline__ int lds_byte(int r, int c) { const int st = (r >> 4) * 2 + (c >> 5), rr = r & 15, cc = c & 31, ob = rr * 64 + cc * 2; return st * 1024 + (ob ^ (((ob >> 9) & 1) << 5)); }
__host__ __device__ __forceinline__ void stage_rc(int b, int& R, int& C) { const int st = b / 1024, sb = b % 1024, swz = sb ^ (((sb >> 9) & 1) << 5); R = (st >> 1) * 16 + swz / 64; C = (st & 1) * 32 + (swz % 64) / 2; }
__host__ __device__ __forceinline__ int perm32(int rho) { const int n = rho >> 4, i = rho & 15; return 8 * (i >> 2) + 4 * n + (i & 3); }

struct Unit { int pm, pn; };
struct Gemm { const bf16_t* A; const bf16_t* Bt; int M, N, K; };

struct StaticOrder {
    int nM, nN, nwg, G, c;
    __host__ __device__ void init(int M, int N, int G_, int c_) { nM = M / BM; nN = N / BM; nwg = nM * nN; G = G_; c = c_; }
    __host__ __device__ bool next(int i, Unit& u) const {
        const long L = (long)i * G + c; if (L >= nwg) return false;
        int wgid = (int)L; { const int q = nwg / NXCD, r = nwg % NXCD, xcd = wgid % NXCD, off = wgid / NXCD; wgid = (xcd < r ? xcd * (q + 1) : r * (q + 1) + (xcd - r) * q) + off; }
        const int nig = WGM * nN, gid = wgid / nig, fm = gid * WGM, gsz = (nM - fm) < WGM ? (nM - fm) : WGM;
        u.pm = fm + ((wgid % nig) % gsz); u.pn = (wgid % nig) / gsz; return true;
    }
    __device__ __forceinline__ void a_ready(const Unit&) const {}
    __device__ __forceinline__ void done(const Unit&) const {}
};

__device__ __forceinline__ unsigned cvt_pk_bf16(float lo, float hi) { unsigned r; asm volatile("v_cvt_pk_bf16_f32 %0, %1, %2" : "=v"(r) : "v"(lo), "v"(hi)); return r; }
typedef float f32x2 __attribute__((ext_vector_type(2)));
__device__ __forceinline__ f32x2 gelu_pk(f32x2 v) {
    const f32x2 av = __builtin_elementwise_abs(v), d = av * 0.2316418882f + 1.0f;
    f32x2 t; t.x = __builtin_amdgcn_rcpf(d.x); t.y = __builtin_amdgcn_rcpf(d.y);
    f32x2 q = t * 0.5307027145f + (-0.7265760135f); q = q * t + 0.7107068705f; q = q * t + (-0.142248368f); q = q * t + 0.127414796f; q = q * t;
    const f32x2 s = (v * v) * (-0.72134752044f);
    f32x2 e; e.x = __builtin_amdgcn_exp2f(s.x); e.y = __builtin_amdgcn_exp2f(s.y);
    const f32x2 m = v * (q * e), r = v - m;
    f32x2 o; o.x = v.x < 0.f ? m.x : r.x; o.y = v.y < 0.f ? m.y : r.y; return o;
}

template <int ACT  > struct EpiBf16 {
    static constexpr bool PERM = true, AFTER_DRAIN = false; static_assert(ACT == 0 || ACT == 1, "EpiBf16: ACT is 0 (none) or 1 (gelu_pk)");
    bf16_t* O; int ldc; const float* bias; int split_cols; size_t split_stride; float scale0;
    __device__ __forceinline__ void operator()(const f32x4 (&acc)[2][2][4][2], const Unit& u, int wr, int wc, int fr, int fq) const {
        const int row0 = u.pm * BM + wr * 64 + fr; int colt = u.pn * BM; bf16_t* base = O;
        float sc = 1.f; if (split_cols) { const int t = colt / split_cols; base += (size_t)t * split_stride; colt -= t * split_cols; if (t == 0) sc = scale0; }
        const int col0 = colt + wc * 32 + 8 * fq, bcol0 = u.pn * BM + wc * 32 + 8 * fq;
        f32x4 bv[2][2];
#pragma unroll
        for (int bj = 0; bj < 2; ++bj)
#pragma unroll
            for (int n = 0; n < 2; ++n) bv[bj][n] = bias ? *(const f32x4*)(bias + bcol0 + bj * HALF + 4 * n) : (f32x4){0.f, 0.f, 0.f, 0.f};
#pragma unroll
        for (int ai = 0; ai < 2; ++ai)
#pragma unroll
            for (int m = 0; m < 4; ++m) { bf16_t* rowp = base + (size_t)(row0 + ai * HALF + m * 16) * ldc + col0;
#pragma unroll
                for (int bj = 0; bj < 2; ++bj) { f32x4 v0 = acc[ai][bj][m][0] + bv[bj][0], v1 = acc[ai][bj][m][1] + bv[bj][1];
                    if (ACT == 1) { f32x2 a = gelu_pk((f32x2){v0[0], v0[1]}), b = gelu_pk((f32x2){v0[2], v0[3]}), c = gelu_pk((f32x2){v1[0], v1[1]}), d = gelu_pk((f32x2){v1[2], v1[3]});
                        v0 = (f32x4){a.x, a.y, b.x, b.y}; v1 = (f32x4){c.x, c.y, d.x, d.y}; }
                    v0 = v0 * sc; v1 = v1 * sc; u32x4 w; w.x = cvt_pk_bf16(v0[0], v0[1]); w.y = cvt_pk_bf16(v0[2], v0[3]); w.z = cvt_pk_bf16(v1[0], v1[1]); w.w = cvt_pk_bf16(v1[2], v1[3]);
                    *(u32x4*)(rowp + bj * HALF) = w; } }
    }
};

struct EpiF32 {
    static constexpr bool PERM = true, AFTER_DRAIN = false;
    float* O; int ldc;
    __device__ __forceinline__ void operator()(const f32x4 (&acc)[2][2][4][2], const Unit& u, int wr, int wc, int fr, int fq) const {
        const int row0 = u.pm * BM + wr * 64 + fr, col0 = u.pn * BM + wc * 32 + 8 * fq;
#pragma unroll
        for (int ai = 0; ai < 2; ++ai)
#pragma unroll
            for (int m = 0; m < 4; ++m) { float* rowp = O + (size_t)(row0 + ai * HALF + m * 16) * ldc + col0;
#pragma unroll
                for (int bj = 0; bj < 2; ++bj) { *(f32x4*)(rowp + bj * HALF) = acc[ai][bj][m][0]; *(f32x4*)(rowp + bj * HALF + 4) = acc[ai][bj][m][1]; } }
    }
};
template <class Epi, class Sched, bool ALIGN_EPI = false, bool SP2 = false>
__device__ __forceinline__ void gemm_phase(PG8_LAS unsigned char* lds, const Gemm g, const Sched& S, const Epi& E) {
    const int tid = threadIdx.x, wid = __builtin_amdgcn_readfirstlane(tid >> 6), lane = tid & 63, wr = wid >> 2, wc = wid & 3, fr = lane & 15, fq = lane >> 4;
    const int K = g.K, nt = K / BK;
    unsigned voffA[2], voffB[2];
#pragma unroll
    for (int i = 0; i < 2; ++i) { int R, C; stage_rc(tid * 16 + i * 8192, R, C); const int Rb = Epi::PERM ? ((R & ~31) + perm32(R & 31)) : R;
        voffA[i] = (unsigned)(R * K + C) * 2u; voffB[i] = (unsigned)(Rb * K + C) * 2u; }
    const size_t kstep = (size_t)(BK * 2);
    const size_t hstep = (size_t)HALF * K * 2;
    const size_t tstep = 2 * hstep;
    const unsigned ldsw = (unsigned)wid * 1024u;
    const int aoff = lds_byte(wr * 64 + fr, fq * 8), boff = lds_byte(wc * 32 + fr, fq * 8);
#define PG8_SA(b, h) (((b) * 2 + (h)) * HTB)
#define PG8_SB(b, h) ((4 + (b) * 2 + (h)) * HTB)
#define PG8_STAGE(bufoff, gbase, voff) do { _Pragma("unroll") for (int _i = 0; _i < 2; ++_i) \
        __builtin_amdgcn_global_load_lds((const unsigned*)((const char*)(gbase) + (voff)[_i]), (PG8_LAS unsigned*)(lds + (bufoff) + ldsw + _i * 8192), 16, 0, 0); } while (0)
#define PG8_LDA(dst, b, h) do { _Pragma("unroll") for (int m = 0; m < 4; ++m) _Pragma("unroll") for (int k = 0; k < 2; ++k) dst[m][k] = *(const PG8_LAS bf16x8*)(lds + PG8_SA(b, h) + aoff + m * 2048 + k * 1024); } while (0)
#define PG8_LDB(dst, b, h) do { _Pragma("unroll") for (int n = 0; n < 2; ++n) _Pragma("unroll") for (int k = 0; k < 2; ++k) dst[n][k] = *(const PG8_LAS bf16x8*)(lds + PG8_SB(b, h) + boff + n * 2048 + k * 1024); } while (0)
#define PG8_MMA(ai, bj, At, Bt) do { __builtin_amdgcn_s_setprio(1); _Pragma("unroll") for (int m = 0; m < 4; ++m) _Pragma("unroll") for (int n = 0; n < 2; ++n) _Pragma("unroll") for (int k = 0; k < 2; ++k) \
        acc[ai][bj][m][n] = __builtin_amdgcn_mfma_f32_16x16x32_bf16(Bt[n][k], At[m][k], acc[ai][bj][m][n], 0, 0, 0); __builtin_amdgcn_s_setprio(0); } while (0)
#define PG8_WAIT_V(n) asm volatile("s_waitcnt vmcnt(" #n ")" ::: "memory")
#define PG8_WAIT_L(n) asm volatile("s_waitcnt lgkmcnt(" #n ")" ::: "memory")
#define PG8_BAR __builtin_amdgcn_s_barrier()
#define PG8_SCHED __builtin_amdgcn_sched_barrier(0)
    Unit cur, nxt; int ui = 0;
    if (!S.next(0, cur)) return;
    f32x4 acc[2][2][4][2];
#pragma unroll
    for (int a = 0; a < 2; ++a)
#pragma unroll
        for (int b = 0; b < 2; ++b)
#pragma unroll
            for (int m = 0; m < 4; ++m)
#pragma unroll
                for (int n = 0; n < 2; ++n) acc[a][b][m][n] = (f32x4){0.f, 0.f, 0.f, 0.f};
    bf16x8 At[4][2], B0[2][2], B1[2][2];
    const char* cA = (const char*)g.A + (size_t)cur.pm * tstep; const char* cB = (const char*)g.Bt + (size_t)cur.pn * tstep;
    S.a_ready(cur);
    if constexpr (SP2) {
        PG8_STAGE(PG8_SB(0, 0), cB, voffB); PG8_STAGE(PG8_SB(0, 1), cB + hstep, voffB); PG8_STAGE(PG8_SA(0, 0), cA, voffA); PG8_STAGE(PG8_SA(0, 1), cA + hstep, voffA);
        if (wr == 1) PG8_BAR;
        PG8_WAIT_V(2); PG8_BAR;
        PG8_STAGE(PG8_SB(1, 0), cB + kstep, voffB); PG8_STAGE(PG8_SA(1, 0), cA + kstep, voffA); PG8_STAGE(PG8_SB(1, 1), cB + hstep + kstep, voffB);
        PG8_WAIT_V(6); PG8_BAR;
    } else {
        PG8_STAGE(PG8_SB(0, 0), cB, voffB); PG8_STAGE(PG8_SA(0, 0), cA, voffA); PG8_STAGE(PG8_SB(0, 1), cB + hstep, voffB); PG8_STAGE(PG8_SA(0, 1), cA + hstep, voffA);
        if (wr == 1) PG8_BAR;
        PG8_WAIT_V(4); PG8_BAR;
        PG8_STAGE(PG8_SB(1, 0), cB + kstep, voffB); PG8_STAGE(PG8_SA(1, 0), cA + kstep, voffA); PG8_STAGE(PG8_SB(1, 1), cB + hstep + kstep, voffB);
        PG8_WAIT_V(6); PG8_BAR;
    }
    for (;;) {
        const bool has_next = S.next(ui + 1, nxt);
        const char* nA = has_next ? (const char*)g.A + (size_t)nxt.pm * tstep : cA; const char* nB = has_next ? (const char*)g.Bt + (size_t)nxt.pn * tstep : cB;
        for (int t = 0; t < nt; t += 2) {
            const bool last = (t == nt - 2);
            const char* a1 = cA + (size_t)(t + 1) * kstep;
            const char* a2 = last ? nA : cA + (size_t)(t + 2) * kstep; const char* b2 = last ? nB : cB + (size_t)(t + 2) * kstep;
            const char* a3 = a2 + kstep; const char* b3 = b2 + kstep;
            if (last && has_next) S.a_ready(nxt);
            if constexpr (SP2) {
            PG8_LDB(B0, 0, 0); PG8_LDB(B1, 0, 1); PG8_SCHED; PG8_LDA(At, 0, 0); PG8_STAGE(PG8_SA(1, 1), a1 + hstep, voffA);
            PG8_WAIT_V(8); PG8_WAIT_L(0); PG8_BAR; PG8_MMA(0, 0, At, B0); PG8_MMA(0, 1, At, B1); PG8_BAR; PG8_SCHED;
            PG8_LDA(At, 0, 1); PG8_STAGE(PG8_SB(0, 0), b2, voffB); PG8_STAGE(PG8_SB(0, 1), b2 + hstep, voffB); PG8_STAGE(PG8_SA(0, 0), a2, voffA);
            PG8_WAIT_V(8); PG8_WAIT_L(0); PG8_BAR; PG8_MMA(1, 0, At, B0); PG8_MMA(1, 1, At, B1); PG8_BAR; PG8_SCHED;
            PG8_LDB(B0, 1, 0); PG8_LDB(B1, 1, 1); PG8_SCHED; PG8_LDA(At, 1, 0); PG8_STAGE(PG8_SA(0, 1), a2 + hstep, voffA);
            PG8_WAIT_V(8); PG8_WAIT_L(0); PG8_BAR; PG8_MMA(0, 0, At, B0); PG8_MMA(0, 1, At, B1); PG8_BAR; PG8_SCHED;
            PG8_LDA(At, 1, 1); PG8_STAGE(PG8_SB(1, 0), b3, voffB); PG8_STAGE(PG8_SB(1, 1), b3 + hstep, voffB); PG8_STAGE(PG8_SA(1, 0), a3, voffA);
            PG8_WAIT_V(8); PG8_WAIT_L(0); PG8_BAR; PG8_MMA(1, 0, At, B0); PG8_MMA(1, 1, At, B1); PG8_BAR; PG8_SCHED;
            } else {
            PG8_LDB(B0, 0, 0); PG8_SCHED; PG8_LDA(At, 0, 0); PG8_STAGE(PG8_SA(1, 1), a1 + hstep, voffA);
            PG8_WAIT_L(8); PG8_BAR; PG8_WAIT_L(0); PG8_MMA(0, 0, At, B0); PG8_BAR; PG8_SCHED;
            PG8_LDB(B1, 0, 1); PG8_STAGE(PG8_SB(0, 0), b2, voffB);
            PG8_BAR; PG8_WAIT_L(0); PG8_MMA(0, 1, At, B1); PG8_BAR;
            PG8_LDA(At, 0, 1); PG8_STAGE(PG8_SA(0, 0), a2, voffA);
            PG8_BAR; PG8_WAIT_L(0); PG8_MMA(1, 0, At, B0); PG8_BAR; PG8_SCHED;
            PG8_STAGE(PG8_SB(0, 1), b2 + hstep, voffB);
            PG8_WAIT_V(6); PG8_BAR; PG8_MMA(1, 1, At, B1); PG8_BAR;
            PG8_LDB(B0, 1, 0); PG8_SCHED; PG8_LDA(At, 1, 0); PG8_STAGE(PG8_SA(0, 1), a2 + hstep, voffA);
            PG8_WAIT_L(8); PG8_BAR; PG8_WAIT_L(0); PG8_MMA(0, 0, At, B0); PG8_BAR; PG8_SCHED;
            PG8_LDB(B1, 1, 1); PG8_STAGE(PG8_SB(1, 0), b3, voffB);
            PG8_BAR; PG8_WAIT_L(0); PG8_MMA(0, 1, At, B1); PG8_BAR;
            PG8_LDA(At, 1, 1); PG8_STAGE(PG8_SA(1, 0), a3, voffA);
            PG8_BAR; PG8_WAIT_L(0); PG8_MMA(1, 0, At, B0); PG8_BAR; PG8_SCHED;
            PG8_STAGE(PG8_SB(1, 1), b3 + hstep, voffB);
            PG8_WAIT_V(6); PG8_BAR; PG8_MMA(1, 1, At, B1); PG8_BAR;
            }
        }
        if constexpr (ALIGN_EPI) { if (wr == 0) PG8_BAR; }
        if constexpr (!Epi::AFTER_DRAIN) { E(acc, cur, wr, wc, fr, fq); S.done(cur); }
        if (!has_next) break;
#pragma unroll
        for (int a = 0; a < 2; ++a)
#pragma unroll
            for (int b = 0; b < 2; ++b)
#pragma unroll
                for (int m = 0; m < 4; ++m)
#pragma unroll
                    for (int n = 0; n < 2; ++n) acc[a][b][m][n] = (f32x4){0.f, 0.f, 0.f, 0.f};
        cur = nxt; cA = nA; cB = nB; ++ui;
        if constexpr (ALIGN_EPI) { if (wr == 1) PG8_BAR; }
    }
    PG8_WAIT_V(0);
    if constexpr (!ALIGN_EPI) { if (wr == 0) PG8_BAR; }
    PG8_BAR;
    if constexpr (Epi::AFTER_DRAIN) { E.fused(acc, cur, wr, wc, fr, fq, lds, wid, lane); S.done(cur); }
#undef PG8_SA
#undef PG8_SB
#undef PG8_STAGE
#undef PG8_LDA
#undef PG8_LDB
#undef PG8_MMA
#undef PG8_WAIT_V
#undef PG8_WAIT_L
#undef PG8_BAR
#undef PG8_SCHED
}
}

struct Frame {
    unsigned char* lds;
    int tid, lane, wave, vcu, G;
    const float *x, *w_in, *w_gate, *b_gate, *gla_g, *sb_g, *w_out, *ln1_g, *ln1_b, *w_q, *sub_keys, *pu, *pv, *ln2_g, *ln2_b;
    float* out;
    unsigned char* ws;
};
#define WSP(type, off) ((type*)(F.ws + (off)))

__device__ __forceinline__ void p0_transpose_item(const float* W, int K, int ldw, int c0, int ncols, bf16* WT, int row_off, float* scr, int item, int lane) {
    const int nblk = ncols / 32, kb = item / nblk, nb = item % nblk, k0 = 64 * kb, n0 = 32 * nb;
#pragma unroll 8
    for (int i = 0; i < 32; ++i) { const int kk = 2 * i + (lane >> 5); scr[kk * 33 + (lane & 31)] = W[(size_t)(k0 + kk) * ldw + c0 + n0 + (lane & 31)]; }
    asm volatile("s_waitcnt lgkmcnt(0)" ::: "memory");
    const int c = lane & 7;
#pragma unroll
    for (int j = 0; j < 4; ++j) { const int n = (lane >> 3) + 8 * j; const float* s = scr + (8 * c) * 33 + n;
        v4u o; o.x = pk2(s[0 * 33], s[1 * 33]); o.y = pk2(s[2 * 33], s[3 * 33]); o.z = pk2(s[4 * 33], s[5 * 33]); o.w = pk2(s[6 * 33], s[7 * 33]);
        *(v4u*)(WT + (size_t)(row_off + n0 + n) * K + k0 + 8 * c) = o; }
    asm volatile("s_waitcnt lgkmcnt(0)" ::: "memory");
}
__device__ __forceinline__ void cvt_f32_bf16_bulk(Frame& F, const float* src, bf16* dst, size_t n8) {
    const size_t gt = (size_t)F.vcu * NTHR + F.tid, NT = (size_t)F.G * NTHR;
    for (size_t i = gt; i < n8; i += NT) {
        const f32x4 a = *(const f32x4*)(src + i * 8), b = *(const f32x4*)(src + i * 8 + 4);
        v4u o; o.x = pk2(a.x, a.y); o.y = pk2(a.z, a.w); o.z = pk2(b.x, b.y); o.w = pk2(b.z, b.w);
        *(v4u*)(dst + i * 8) = o;
    }
}
__device__ __forceinline__ void ph0_prologue(Frame& F) {
    float* wa = (float*)F.lds;
    float* scr = (float*)(F.lds + 65536 + F.wave * 8448);
    const int gw = F.vcu * NWAVES + F.wave, NGW = F.G * NWAVES;
    for (int idx = F.tid; idx < 16384; idx += NTHR) { const int k = idx >> 4, r = idx & 15; wa[r * 1024 + k] = F.w_in[(size_t)k * INW + A_COL + r]; }
    constexpr int I_IN1 = 16 * 48, I_IN2 = 16 * 48, I_OUT = 16 * 32, I_Q = 16 * 64, NITEMS = I_IN1 + I_IN2 + I_OUT + I_Q;
    for (int it = gw; it < NITEMS; it += NGW) {
        int r = it;
        if (r < I_IN1) { p0_transpose_item(F.w_in, 1024, INW, 0, 1536, WSP(bf16, WS_WTIN), 0, scr, r, F.lane); continue; } r -= I_IN1;
        if (r < I_IN2) { p0_transpose_item(F.w_in, 1024, INW, 1552, 1536, WSP(bf16, WS_WTIN), 1536, scr, r, F.lane); continue; } r -= I_IN2;
        if (r < I_OUT) { p0_transpose_item(F.w_out, 1024, 1024, 0, 1024, WSP(bf16, WS_WTOUT), 0, scr, r, F.lane); continue; } r -= I_OUT;
        p0_transpose_item(F.w_q, 1024, 2048, 0, 2048, WSP(bf16, WS_WTQ), 0, scr, r, F.lane);
    }
    cvt_f32_bf16_bulk(F, F.sub_keys, WSP(bf16, WS_SKB), (size_t)8 * 2 * 128 * 128 / 8);
    cvt_f32_bf16_bulk(F, F.pu, WSP(bf16, WS_UB), (size_t)16384 * 1024 / 8);
    cvt_f32_bf16_bulk(F, F.pv, WSP(bf16, WS_VB), (size_t)16384 * 1024 / 8);
    __syncthreads();
    bf16* xb = WSP(bf16, WS_XB); float* alpha = WSP(float, WS_ALPHA);
    float wgr[16][4], bgr[4];
#pragma unroll
    for (int i = 0; i < 4; ++i) { bgr[i] = F.b_gate[F.lane + 64 * i];
#pragma unroll
        for (int r = 0; r < 16; ++r) wgr[r][i] = F.w_gate[r * 256 + F.lane + 64 * i]; }
    for (int m = gw; m < T; m += NGW) {
        const float* xr = F.x + (size_t)m * DM;
        f32x4 xv[4];
#pragma unroll
        for (int i = 0; i < 4; ++i) { xv[i] = *(const f32x4*)(xr + 256 * i + 4 * F.lane);
            v2u o; o.x = pk2(xv[i].x, xv[i].y); o.y = pk2(xv[i].z, xv[i].w); *(v2u*)(xb + (size_t)m * DM + 256 * i + 4 * F.lane) = o; }
        float sg[4] = {bgr[0], bgr[1], bgr[2], bgr[3]};
#pragma unroll
        for (int r = 0; r < 16; ++r) {
            float a = 0.f;
#pragma unroll
            for (int i = 0; i < 4; ++i) { const f32x4 w = *(const f32x4*)(wa + r * 1024 + 256 * i + 4 * F.lane); a += xv[i].x * w.x + xv[i].y * w.y + xv[i].z * w.z + xv[i].w * w.w; }
            a = wave_sum(a);
#pragma unroll
            for (int i = 0; i < 4; ++i) sg[i] += a * wgr[r][i];
            asm volatile("" ::: "memory");
        }
#pragma unroll
        for (int i = 0; i < 4; ++i) { const float la = -(fmaxf(-sg[i], 0.f) + log1pf(expf(-fabsf(sg[i])))) * (1.0f / 16.0f);
            alpha[(size_t)m * 256 + F.lane + 64 * i] = expf(la); }
    }
}

struct EpiBf16Store { bf16* C; int ldc;
    __device__ __forceinline__ void operator()(int row, int col, const float (&acc)[8][4]) const {
#pragma unroll
        for (int i = 0; i < 8; ++i) { v2u o; o.x = pk2(acc[i][0], acc[i][1]); o.y = pk2(acc[i][2], acc[i][3]); *(v2u*)(C + (size_t)(row + i) * ldc + col) = o; } } };
struct EpiF32Store { float* C; int ldc;
    __device__ __forceinline__ void operator()(int row, int col, const float (&acc)[8][4]) const {
#pragma unroll
        for (int i = 0; i < 8; ++i) *(f32x4*)(C + (size_t)(row + i) * ldc + col) = (f32x4){acc[i][0], acc[i][1], acc[i][2], acc[i][3]}; } };
template <class Epi>
__device__ __forceinline__ void naive_gemm(Frame& F, const bf16* A, const bf16* Bt, int M, int N, int K, const Epi& epi) {
    float* As = (float*)F.lds; float* Bs = As + 32 * 132;
    const int tid = F.tid, tm = tid >> 5, tn = tid & 31, lr = tid >> 2, lk = (tid & 3) * 8;
    const int nN = N / 128, nU = (M / 128) * nN;
    for (int u = F.vcu; u < nU; u += F.G) {
        const int pm = u / nN, pn = u % nN;
        float acc[8][4];
#pragma unroll
        for (int i = 0; i < 8; ++i)
#pragma unroll
            for (int j = 0; j < 4; ++j) acc[i][j] = 0.f;
        const bf16* ap = A + (size_t)(pm * 128 + lr) * K + lk; const bf16* bp = Bt + (size_t)(pn * 128 + lr) * K + lk;
        for (int k0 = 0; k0 < K; k0 += 32) {
            const v4u av = *(const v4u*)(ap + k0), bv = *(const v4u*)(bp + k0);
            __syncthreads();
#pragma unroll
            for (int j = 0; j < 4; ++j) {
                As[(lk + 2 * j) * 132 + lr] = __uint_as_float(av[j] << 16); As[(lk + 2 * j + 1) * 132 + lr] = __uint_as_float(av[j] & 0xffff0000u);
                Bs[(lk + 2 * j) * 132 + lr] = __uint_as_float(bv[j] << 16); Bs[(lk + 2 * j + 1) * 132 + lr] = __uint_as_float(bv[j] & 0xffff0000u); }
            __syncthreads();
#pragma unroll 4
            for (int k = 0; k < 32; ++k) {
                const f32x4 a0 = *(const f32x4*)(As + k * 132 + tm * 8), a1 = *(const f32x4*)(As + k * 132 + tm * 8 + 4), b = *(const f32x4*)(Bs + k * 132 + tn * 4);
                const float a[8] = {a0.x, a0.y, a0.z, a0.w, a1.x, a1.y, a1.z, a1.w}; const float bb[4] = {b.x, b.y, b.z, b.w};
#pragma unroll
                for (int i = 0; i < 8; ++i)
#pragma unroll
                    for (int j = 0; j < 4; ++j) acc[i][j] += a[i] * bb[j];
            }
        }
        epi(pm * 128 + tm * 8, pn * 128 + tn * 4, acc);
    }
    __syncthreads();
}

template <bool OUT>
__device__ __forceinline__ void gla_chunk_pass(Frame& F) {
    const bf16* proj = WSP(bf16, WS_PROJ); const float* alpha = WSP(float, WS_ALPHA); bf16* cat = WSP(bf16, WS_CAT);
    float* sloc = WSP(float, WS_SLOC); float* dec = WSP(float, WS_DEC);
    float* qs = (float*)F.lds; float* ks = qs + 4096; float* as = ks + 4096; float* os = as + 4096;
    const int tid = F.tid, lane = F.lane, e = 16 * F.wave + (lane & 15), cg = lane >> 4;
    for (int u = F.vcu; u < 1024; u += F.G) {
        const int bh = u >> 7, ch = u & 127, b = bh >> 2, h = bh & 3; const size_t row0 = (size_t)b * SEQ + ch * 64;
        __syncthreads();
        for (int i = tid; i < 4096; i += NTHR) { const int tt = i >> 6, c = i & 63; const size_t row = row0 + tt;
            if (OUT) qs[i] = bf2f(proj[row * NPJ + C_QG + h * 64 + c]) * 0.125f;
            ks[i] = bf2f(proj[row * NPJ + C_KG + h * 64 + c]);
            as[i] = alpha[row * 256 + h * 64 + c]; }
        float S[16];
#pragma unroll
        for (int i = 0; i < 16; ++i) S[i] = OUT ? sloc[(size_t)u * 8192 + (16 * cg + i) * 128 + e] : 0.f;
        __syncthreads();
        if (!OUT) {
            for (int tt = 0; tt < 64; ++tt) { const float v = bf2f(proj[(row0 + tt) * NPJ + C_VG + h * 128 + e]);
#pragma unroll
                for (int i = 0; i < 16; ++i) S[i] = S[i] * as[tt * 64 + 16 * cg + i] + ks[tt * 64 + 16 * cg + i] * v; }
#pragma unroll
            for (int i = 0; i < 16; ++i) sloc[(size_t)u * 8192 + (16 * cg + i) * 128 + e] = S[i];
            if (tid < 64) { float d = 1.f; for (int tt = 0; tt < 64; ++tt) d *= as[tt * 64 + tid]; dec[(size_t)u * 64 + tid] = d; }
        } else {
            for (int t0 = 0; t0 < 64; t0 += 16) {
                for (int tt = t0; tt < t0 + 16; ++tt) { const float v = bf2f(proj[(row0 + tt) * NPJ + C_VG + h * 128 + e]); float o = 0.f;
#pragma unroll
                    for (int i = 0; i < 16; ++i) { S[i] = S[i] * as[tt * 64 + 16 * cg + i] + ks[tt * 64 + 16 * cg + i] * v; o += qs[tt * 64 + 16 * cg + i] * S[i]; }
                    o += __shfl_xor(o, 16); o += __shfl_xor(o, 32);
                    if (cg == 0) os[(tt - t0) * 128 + e] = o; }
                __syncthreads();
#pragma unroll
                for (int j = 0; j < 2; ++j) { const int tt = F.wave * 2 + j; const size_t row = row0 + t0 + tt;
                    const float o0 = os[tt * 128 + lane], o1 = os[tt * 128 + 64 + lane];
                    const float ss = wave_sum(o0 * o0 + o1 * o1); const float r = rsqrtf(ss * (1.0f / 128.0f) + EPS);
                    const float g0 = bf2f(proj[row * NPJ + C_GG + h * 128 + lane]), g1 = bf2f(proj[row * NPJ + C_GG + h * 128 + 64 + lane]);
                    const float y0 = o0 * r * F.gla_g[h * 128 + lane] * (g0 / (1.f + expf(-g0)));
                    const float y1 = o1 * r * F.gla_g[h * 128 + 64 + lane] * (g1 / (1.f + expf(-g1)));
                    cat[row * DM + h * 128 + lane] = (bf16)f2bf(y0); cat[row * DM + h * 128 + 64 + lane] = (bf16)f2bf(y1); }
                __syncthreads();
            }
        }
    }
    __syncthreads();
}
__device__ __forceinline__ void gla_scan(Frame& F) {
    float* sloc = WSP(float, WS_SLOC); const float* dec = WSP(float, WS_DEC);
    const int g = F.vcu * NTHR + F.tid;
    if (g >= 65536) return;
    const int bh = g >> 13, ce = g & 8191, c = ce >> 7;
    float* sp = sloc + (size_t)bh * 128 * 8192 + ce; const float* dp = dec + (size_t)bh * 128 * 64 + c;
    float S = 0.f; float v[8], d[8];
#pragma unroll
    for (int j = 0; j < 8; ++j) { v[j] = sp[(size_t)j * 8192]; d[j] = dp[j * 64]; }
    for (int s0 = 0; s0 < 128; s0 += 8) {
        float vn[8], dn[8];
        const int s1 = (s0 + 8 < 128) ? s0 + 8 : s0;
#pragma unroll
        for (int j = 0; j < 8; ++j) { vn[j] = sp[(size_t)(s1 + j) * 8192]; dn[j] = dp[(s1 + j) * 64]; }
#pragma unroll
        for (int j = 0; j < 8; ++j) { sp[(size_t)(s0 + j) * 8192] = S; S = S * d[j] + v[j]; }
#pragma unroll
        for (int j = 0; j < 8; ++j) { v[j] = vn[j]; d[j] = dn[j]; }
    }
}
__device__ __forceinline__ void ph2_sb_naive(Frame& F) {
    const bf16* proj = WSP(bf16, WS_PROJ); bf16* cat = WSP(bf16, WS_CAT);
    float* Ks = (float*)F.lds; float* Vs = Ks + 32 * 64;
    const int tid = F.tid;
    for (int u = F.vcu; u < 256; u += F.G) {
        const int bh = u >> 4, qb = u & 15, b = bh >> 3, h = bh & 7, t = qb * 512 + tid; const size_t row = (size_t)b * SEQ + t;
        float q[64], o[64];
#pragma unroll
        for (int i = 0; i < 8; ++i) { const v4u w = *(const v4u*)(proj + row * NPJ + C_QS + h * 64 + 8 * i);
#pragma unroll
            for (int j = 0; j < 4; ++j) { q[8 * i + 2 * j] = __uint_as_float(w[j] << 16) * 0.125f; q[8 * i + 2 * j + 1] = __uint_as_float(w[j] & 0xffff0000u) * 0.125f; } }
#pragma unroll
        for (int d = 0; d < 64; ++d) o[d] = 0.f;
        float tail = 0.f;
        for (int kt = (qb * 512 + 511) / 32; kt >= 0; --kt) {
            if (__syncthreads_and(tail < -SB_EXIT_NAT)) break;
            { const int key = tid >> 4, d4 = (tid & 15) * 4; const size_t krow = (size_t)b * SEQ + kt * 32 + key;
              const v2u kk = *(const v2u*)(proj + krow * NPJ + C_KS + h * 64 + d4), vv = *(const v2u*)(proj + krow * NPJ + C_VS + h * 64 + d4);
              *(f32x4*)(Ks + key * 64 + d4) = (f32x4){__uint_as_float(kk.x << 16), __uint_as_float(kk.x & 0xffff0000u), __uint_as_float(kk.y << 16), __uint_as_float(kk.y & 0xffff0000u)};
              *(f32x4*)(Vs + key * 64 + d4) = (f32x4){__uint_as_float(vv.x << 16), __uint_as_float(vv.x & 0xffff0000u), __uint_as_float(vv.y << 16), __uint_as_float(vv.y & 0xffff0000u)}; }
            __syncthreads();
            for (int j = 31; j >= 0; --j) {
                const int s = kt * 32 + j;
                float z = 0.f;
#pragma unroll
                for (int d4 = 0; d4 < 16; ++d4) { const f32x4 k4 = *(const f32x4*)(Ks + j * 64 + 4 * d4); z += q[4 * d4] * k4.x + q[4 * d4 + 1] * k4.y + q[4 * d4 + 2] * k4.z + q[4 * d4 + 3] * k4.w; }
                const bool valid = s < t;
                const float lnb = logsig_neg(z);
                const float w = valid ? expf(z + lnb + tail) : 0.f;
                tail += valid ? lnb : 0.f;
#pragma unroll
                for (int d4 = 0; d4 < 16; ++d4) { const f32x4 v4 = *(const f32x4*)(Vs + j * 64 + 4 * d4); o[4 * d4] += w * v4.x; o[4 * d4 + 1] += w * v4.y; o[4 * d4 + 2] += w * v4.z; o[4 * d4 + 3] += w * v4.w; }
            }
        }
        float ss = 0.f;
#pragma unroll
        for (int d = 0; d < 64; ++d) ss += o[d] * o[d];
        const float r = rsqrtf(ss * (1.0f / 64.0f) + EPS);
#pragma unroll
        for (int i = 0; i < 8; ++i) { v4u w;
#pragma unroll
            for (int j = 0; j < 4; ++j) w[j] = pk2(o[8 * i + 2 * j] * r * F.sb_g[h * 64 + 8 * i + 2 * j], o[8 * i + 2 * j + 1] * r * F.sb_g[h * 64 + 8 * i + 2 * j + 1]);
            *(v4u*)(cat + row * DM + 512 + h * 64 + 8 * i) = w; }
    }
    __syncthreads();
}

__device__ __forceinline__ void ph4_ln1(Frame& F) {
    const int gw = F.vcu * NWAVES + F.wave, NGW = F.G * NWAVES;
    float* x1 = WSP(float, WS_X1); bf16* x1b = WSP(bf16, WS_X1B);
    for (int m = gw; m < T; m += NGW) {
        f32x4 y[4]; float s = 0.f;
#pragma unroll
        for (int i = 0; i < 4; ++i) { const size_t o = (size_t)m * DM + 256 * i + 4 * F.lane; y[i] = *(const f32x4*)(F.x + o) * ALPHA + *(const f32x4*)(F.out + o); s += (y[i].x + y[i].y) + (y[i].z + y[i].w); }
        const float mean = wave_sum(s) * (1.0f / DM); float q = 0.f;
#pragma unroll
        for (int i = 0; i < 4; ++i) { y[i] = y[i] - mean; q += (y[i].x * y[i].x + y[i].y * y[i].y) + (y[i].z * y[i].z + y[i].w * y[i].w); }
        const float rstd = rsqrtf(wave_sum(q) * (1.0f / DM) + EPS);
#pragma unroll
        for (int i = 0; i < 4; ++i) { const int c = 256 * i + 4 * F.lane; const size_t o = (size_t)m * DM + c;
            const f32x4 r = y[i] * rstd * *(const f32x4*)(F.ln1_g + c) + *(const f32x4*)(F.ln1_b + c);
            *(f32x4*)(x1 + o) = r; v2u w; w.x = pk2(r.x, r.y); w.y = pk2(r.z, r.w); *(v2u*)(x1b + o) = w; }
    }
}

#define TOPK_INSERT(cv, ci, VAL, IDX) do { float _cv = (cv); int _ci = (ci); \
    _Pragma("unroll") for (int _j = 0; _j < 16; ++_j) { const bool _g = _cv > VAL[_j]; const float _tv = VAL[_j]; const int _ti = IDX[_j]; \
        VAL[_j] = _g ? _cv : _tv; IDX[_j] = _g ? _ci : _ti; _cv = _g ? _tv : _cv; _ci = _g ? _ti : _ci; } } while (0)
__device__ __forceinline__ void ph6_topk_naive(Frame& F) {
    const bf16* qry = WSP(bf16, WS_QRY); const bf16* skb = WSP(bf16, WS_SKB);
    int* pidx = WSP(int, WS_PIDX); float* pgate = WSP(float, WS_PGATE);
    float* sk = (float*)F.lds;
    const int tid = F.tid;
    for (int u = F.vcu; u < 256; u += F.G) {
        const int h = u >> 5, tb = u & 31, t = tb * 512 + tid;
        float sv[2][16]; int si[2][16];
#pragma unroll
        for (int p = 0; p < 2; ++p) {
            __syncthreads();
            for (int i = tid; i < 128 * 128 / 2; i += NTHR) { const unsigned w = *(const unsigned*)(skb + (size_t)(h * 2 + p) * 16384 + 2 * i); sk[2 * i] = __uint_as_float(w << 16); sk[2 * i + 1] = __uint_as_float(w & 0xffff0000u); }
            __syncthreads();
            unsigned qp[64];
#pragma unroll
            for (int i = 0; i < 16; ++i) { const v4u w = *(const v4u*)(qry + (size_t)t * 2048 + h * 256 + p * 128 + 8 * i); qp[4 * i] = w.x; qp[4 * i + 1] = w.y; qp[4 * i + 2] = w.z; qp[4 * i + 3] = w.w; }
#pragma unroll
            for (int j = 0; j < 16; ++j) { sv[p][j] = -INFINITY; si[p][j] = 0; }
            for (int n = 0; n < 128; ++n) {
                float s = 0.f;
#pragma unroll
                for (int c4 = 0; c4 < 32; ++c4) { const f32x4 k4 = *(const f32x4*)(sk + n * 128 + 4 * c4);
                    s += __uint_as_float(qp[2 * c4] << 16) * k4.x + __uint_as_float(qp[2 * c4] & 0xffff0000u) * k4.y + __uint_as_float(qp[2 * c4 + 1] << 16) * k4.z + __uint_as_float(qp[2 * c4 + 1] & 0xffff0000u) * k4.w; }
                TOPK_INSERT(s, n, sv[p], si[p]);
            }
        }
        float bv[16]; int bi[16];
#pragma unroll
        for (int j = 0; j < 16; ++j) { bv[j] = -INFINITY; bi[j] = 0; }
#pragma unroll
        for (int i = 0; i < 16; ++i)
#pragma unroll
            for (int j = 0; j < 16; ++j) TOPK_INSERT(sv[0][i] + sv[1][j], si[0][i] * 128 + si[1][j], bv, bi);
        float den = 0.f; float e[16];
#pragma unroll
        for (int j = 0; j < 16; ++j) { e[j] = expf(bv[j] - bv[0]); den += e[j]; }
        const float inv = 1.0f / den;
#pragma unroll
        for (int j4 = 0; j4 < 4; ++j4) {
            *(f32x4*)(pgate + (size_t)t * 128 + h * 16 + 4 * j4) = (f32x4){e[4 * j4] * inv, e[4 * j4 + 1] * inv, e[4 * j4 + 2] * inv, e[4 * j4 + 3] * inv};
            *(v4u*)(pidx + (size_t)t * 128 + h * 16 + 4 * j4) = (v4u){(unsigned)bi[4 * j4], (unsigned)bi[4 * j4 + 1], (unsigned)bi[4 * j4 + 2], (unsigned)bi[4 * j4 + 3]};
        }
    }
    __syncthreads();
}

__device__ __forceinline__ void ph7_peer_naive(Frame& F) {
    const int gw = F.vcu * NWAVES + F.wave, NGW = F.G * NWAVES;
    const float* x1 = WSP(float, WS_X1); const int* pidx = WSP(int, WS_PIDX); const float* pgate = WSP(float, WS_PGATE);
    for (int m = gw; m < T; m += NGW) {
        f32x4 xv[4], acc[4];
#pragma unroll
        for (int i = 0; i < 4; ++i) { xv[i] = *(const f32x4*)(x1 + (size_t)m * DM + 256 * i + 4 * F.lane); acc[i] = (f32x4){0.f, 0.f, 0.f, 0.f}; }
        for (int k = 0; k < 128; ++k) {
            const int e = __builtin_amdgcn_readfirstlane(pidx[(size_t)m * 128 + k]); const float g = pgate[(size_t)m * 128 + k];
            const float* ur = F.pu + (size_t)e * DM; const float* vr = F.pv + (size_t)e * DM;
            float p = 0.f;
#pragma unroll
            for (int i = 0; i < 4; ++i) { const f32x4 uu = *(const f32x4*)(ur + 256 * i + 4 * F.lane); p += (uu.x * xv[i].x + uu.y * xv[i].y) + (uu.z * xv[i].z + uu.w * xv[i].w); }
            p = wave_sum(p);
            const float w = g * 0.5f * p * (1.0f + erff(p * 0.70710678118654752f));
#pragma unroll
            for (int i = 0; i < 4; ++i) acc[i] += *(const f32x4*)(vr + 256 * i + 4 * F.lane) * w;
        }
        float s = 0.f;
#pragma unroll
        for (int i = 0; i < 4; ++i) { acc[i] = xv[i] * ALPHA + acc[i]; s += (acc[i].x + acc[i].y) + (acc[i].z + acc[i].w); }
        const float mean = wave_sum(s) * (1.0f / DM); float q = 0.f;
#pragma unroll
        for (int i = 0; i < 4; ++i) { acc[i] = acc[i] - mean; q += (acc[i].x * acc[i].x + acc[i].y * acc[i].y) + (acc[i].z * acc[i].z + acc[i].w * acc[i].w); }
        const float rstd = rsqrtf(wave_sum(q) * (1.0f / DM) + EPS);
#pragma unroll
        for (int i = 0; i < 4; ++i) { const int c = 256 * i + 4 * F.lane;
            *(f32x4*)(F.out + (size_t)m * DM + c) = acc[i] * rstd * *(const f32x4*)(F.ln2_g + c) + *(const f32x4*)(F.ln2_b + c); }
    }
}


__device__ __forceinline__ float gelu_erf(float p) { return 0.5f * p * (1.0f + erff(p * 0.70710678118654752f)); }
__device__ __forceinline__ void ph7_peer(Frame& F) {
    const int gw = F.vcu * NWAVES + F.wave, NGW = F.G * NWAVES, lane = F.lane;
    const float* x1 = WSP(float, WS_X1); const int* pidx = WSP(int, WS_PIDX); const float* pgate = WSP(float, WS_PGATE);
    const bf16* UB = WSP(bf16, WS_UB); const bf16* VB = WSP(bf16, WS_VB);
    const bool b5 = (lane & 32) != 0, b4 = (lane & 16) != 0, b3 = (lane & 8) != 0;
    for (int m = gw; m < T; m += NGW) {
        float xv[16], acc[16];
#pragma unroll
        for (int i = 0; i < 2; ++i) { const f32x4 a = *(const f32x4*)(x1 + (size_t)m * DM + 512 * i + 8 * lane), b = *(const f32x4*)(x1 + (size_t)m * DM + 512 * i + 8 * lane + 4);
            xv[8 * i] = a.x; xv[8 * i + 1] = a.y; xv[8 * i + 2] = a.z; xv[8 * i + 3] = a.w; xv[8 * i + 4] = b.x; xv[8 * i + 5] = b.y; xv[8 * i + 6] = b.z; xv[8 * i + 7] = b.w; }
#pragma unroll
        for (int i = 0; i < 16; ++i) acc[i] = 0.f;
        for (int k0 = 0; k0 < 128; k0 += 8) {
            const int ei = pidx[(size_t)m * 128 + k0 + (lane >> 3)]; const float gi = pgate[(size_t)m * 128 + k0 + (lane >> 3)];
            v4u uw[8][2], vw[8][2];
#pragma unroll
            for (int j = 0; j < 8; ++j) { const int e = __builtin_amdgcn_readlane(ei, 8 * j);
#pragma unroll
                for (int i = 0; i < 2; ++i) { uw[j][i] = *(const v4u*)(UB + (size_t)e * DM + 512 * i + 8 * lane); vw[j][i] = *(const v4u*)(VB + (size_t)e * DM + 512 * i + 8 * lane); } }
            float p[8];
#pragma unroll
            for (int j = 0; j < 8; ++j) { float a = 0.f;
#pragma unroll
                for (int i = 0; i < 2; ++i)
#pragma unroll
                    for (int q = 0; q < 4; ++q) { const unsigned w = uw[j][i][q]; a += __uint_as_float(w << 16) * xv[8 * i + 2 * q] + __uint_as_float(w & 0xffff0000u) * xv[8 * i + 2 * q + 1]; }
                p[j] = a; }
            float r1[4], r2[2];
#pragma unroll
            for (int j = 0; j < 4; ++j) r1[j] = (b5 ? p[j + 4] : p[j]) + __shfl_xor(b5 ? p[j] : p[j + 4], 32);
#pragma unroll
            for (int j = 0; j < 2; ++j) r2[j] = (b4 ? r1[j + 2] : r1[j]) + __shfl_xor(b4 ? r1[j] : r1[j + 2], 16);
            float r3 = (b3 ? r2[1] : r2[0]) + __shfl_xor(b3 ? r2[0] : r2[1], 8);
            r3 += __shfl_xor(r3, 4); r3 += __shfl_xor(r3, 2); r3 += __shfl_xor(r3, 1);
            const float wl = gi * gelu_erf(r3);
#pragma unroll
            for (int j = 0; j < 8; ++j) { const float w = __int_as_float(__builtin_amdgcn_readlane(__float_as_int(wl), 8 * j));
#pragma unroll
                for (int i = 0; i < 2; ++i)
#pragma unroll
                    for (int q = 0; q < 4; ++q) { const unsigned vwd = vw[j][i][q]; acc[8 * i + 2 * q] += w * __uint_as_float(vwd << 16); acc[8 * i + 2 * q + 1] += w * __uint_as_float(vwd & 0xffff0000u); } }
        }
        float s = 0.f;
#pragma unroll
        for (int i = 0; i < 16; ++i) { acc[i] = xv[i] * ALPHA + acc[i]; s += acc[i]; }
        const float mean = wave_sum(s) * (1.0f / DM); float q = 0.f;
#pragma unroll
        for (int i = 0; i < 16; ++i) { acc[i] -= mean; q += acc[i] * acc[i]; }
        const float rstd = rsqrtf(wave_sum(q) * (1.0f / DM) + EPS);
#pragma unroll
        for (int i = 0; i < 2; ++i)
#pragma unroll
            for (int hh = 0; hh < 2; ++hh) { const int c = 512 * i + 8 * lane + 4 * hh; const f32x4 g = *(const f32x4*)(F.ln2_g + c), bb = *(const f32x4*)(F.ln2_b + c);
                *(f32x4*)(F.out + (size_t)m * DM + c) = (f32x4){acc[8 * i + 4 * hh] * rstd * g.x + bb.x, acc[8 * i + 4 * hh + 1] * rstd * g.y + bb.y, acc[8 * i + 4 * hh + 2] * rstd * g.z + bb.z, acc[8 * i + 4 * hh + 3] * rstd * g.w + bb.w}; }
    }
}
struct Args { const float* in[15]; float* out; unsigned char* ws; int ph_lo, ph_hi, li, pad; };
__global__ void __launch_bounds__(NTHR, 2) mk_fwd(Args args) {
    extern __shared__ __attribute__((aligned(16))) unsigned char lds[];
    Frame F;
    F.lds = lds; F.tid = threadIdx.x; F.lane = F.tid & 63; F.wave = __builtin_amdgcn_readfirstlane(F.tid >> 6);
    F.G = gridDim.x; { const int bx = blockIdx.x; F.vcu = (F.G % 8 == 0) ? (bx % 8) * (F.G / 8) + bx / 8 : bx; }
    F.x = args.in[0]; F.w_in = args.in[1]; F.w_gate = args.in[2]; F.b_gate = args.in[3]; F.gla_g = args.in[4]; F.sb_g = args.in[5]; F.w_out = args.in[6];
    F.ln1_g = args.in[7]; F.ln1_b = args.in[8]; F.w_q = args.in[9]; F.sub_keys = args.in[10]; F.pu = args.in[11]; F.pv = args.in[12]; F.ln2_g = args.in[13]; F.ln2_b = args.in[14];
    F.out = args.out; F.ws = args.ws;
    volatile LAS unsigned* MISC = (volatile LAS unsigned*)((LAS unsigned char*)lds + MISC_OFF);
    if (F.tid < 32) MISC[F.tid] = 0u;
    __syncthreads();
    unsigned* barw = (unsigned*)(F.ws + WS_CTL) + CW_BAR + args.li * XCD_BAR_WORDS;
    XcdBarrier bar; bar.bar = barw; bar.x = 0; bar.st = nullptr;
    const int lo = args.ph_lo, hi = args.ph_hi;
    if (hi - lo > 1) bar = xcd_barrier_post(barw, MISC + 8);
#ifndef PH_MASK
#define PH_MASK 0x3ff
#endif
#define IN(k) (((PH_MASK >> (k)) & 1) && lo <= (k) && (k) < hi)
#define SEAM(k) do { if (IN(k) && IN((k) + 1)) xcd_barrier(bar); } while (0)
#ifndef NAIVE_MASK
#define NAIVE_MASK 0x00
#endif
#define NV(k) ((NAIVE_MASK >> (k)) & 1)
    LAS unsigned char* const ldsl = (LAS unsigned char*)lds;
    if (IN(0)) { ph0_prologue(F); } SEAM(0);
    if (IN(1)) {
        if (NV(1)) naive_gemm(F, WSP(bf16, WS_XB), WSP(bf16, WS_WTIN), T, NPJ, DM, EpiBf16Store{WSP(bf16, WS_PROJ), NPJ});
        else { pg8::Gemm g{WSP(bf16, WS_XB), WSP(bf16, WS_WTIN), T, NPJ, DM}; pg8::StaticOrder S; S.init(T, NPJ, F.G, (int)blockIdx.x);
            pg8::EpiBf16<0> E{WSP(bf16, WS_PROJ), NPJ, nullptr, 0, 0, 1.f};
            pg8::gemm_phase<pg8::EpiBf16<0>, pg8::StaticOrder, true, true>(ldsl, g, S, E); }
    } SEAM(1);
    if (IN(2)) { gla_chunk_pass<false>(F); ph2_sb_naive(F); } SEAM(2);
    if (IN(3)) { gla_scan(F); } SEAM(3);
    if (IN(4)) { gla_chunk_pass<true>(F); } SEAM(4);
    if (IN(5)) {
        if (NV(5)) naive_gemm(F, WSP(bf16, WS_CAT), WSP(bf16, WS_WTOUT), T, DM, DM, EpiF32Store{F.out, DM});
        else { pg8::Gemm g{WSP(bf16, WS_CAT), WSP(bf16, WS_WTOUT), T, DM, DM}; pg8::StaticOrder S; S.init(T, DM, F.G, (int)blockIdx.x);
            pg8::EpiF32 E{F.out, DM};
            pg8::gemm_phase<pg8::EpiF32, pg8::StaticOrder, true, true>(ldsl, g, S, E); }
    } SEAM(5);
    if (IN(6)) { ph4_ln1(F); } SEAM(6);
    if (IN(7)) {
        if (NV(7)) naive_gemm(F, WSP(bf16, WS_X1B), WSP(bf16, WS_WTQ), T, 2048, DM, EpiBf16Store{WSP(bf16, WS_QRY), 2048});
        else { pg8::Gemm g{WSP(bf16, WS_X1B), WSP(bf16, WS_WTQ), T, 2048, DM}; pg8::StaticOrder S; S.init(T, 2048, F.G, (int)blockIdx.x);
            pg8::EpiBf16<0> E{WSP(bf16, WS_QRY), 2048, nullptr, 0, 0, 1.f};
            pg8::gemm_phase<pg8::EpiBf16<0>, pg8::StaticOrder, true, true>(ldsl, g, S, E); }
    } SEAM(7);
    if (IN(8)) { ph6_topk_naive(F); } SEAM(8);
    if (IN(9)) { if (NV(9)) ph7_peer_naive(F); else ph7_peer(F); }
#undef IN
#undef SEAM
}

extern "C" void kernel_launch(void* const* d_in, const int* in_sizes, int n_in, void* d_out, int out_size, void* d_ws, size_t ws_size, hipStream_t stream) {
    static int grid = 0;
    if (grid == 0) {
        if (n_in != 15 || in_sizes[0] != T * DM || out_size != T * DM || ws_size < WS_END) {
            fprintf(stderr, "kernel_launch: unexpected problem: n_in %d in0 %d out %d ws %zu (need %zu)\n", n_in, n_in > 0 ? in_sizes[0] : -1, out_size, ws_size, (size_t)WS_END); grid = -1; return; }
        int dev = 0, cus = 0;
        if (hipGetDevice(&dev) != hipSuccess || hipDeviceGetAttribute(&cus, hipDeviceAttributeMultiprocessorCount, dev) != hipSuccess) { grid = -1; return; }
        if (hipFuncSetAttribute((const void*)mk_fwd, hipFuncAttributeMaxDynamicSharedMemorySize, LDS_BYTES) != hipSuccess) { fprintf(stderr, "kernel_launch: hipFuncSetAttribute failed\n"); grid = -1; return; }
        (void)hipGetLastError();
        grid = cus;
    }
    if (grid < 0) return;
    if (hipMemsetAsync((char*)d_ws + WS_CTL, 0, CTL_ZERO_BYTES, stream) != hipSuccess) { fprintf(stderr, "kernel_launch: memset failed\n"); return; }
    Args a{};
    for (int i = 0; i < 15; ++i) a.in[i] = (const float*)d_in[i];
    a.out = (float*)d_out; a.ws = (unsigned char*)d_ws;
    constexpr int NL = MK_N_LAUNCHES;
    for (int li = 0; li < NL; ++li) {
        a.ph_lo = (NL == 1) ? 0 : li; a.ph_hi = (NL == 1) ? NPHASE : li + 1; a.li = li;
        hipLaunchKernelGGL(mk_fwd, dim3(grid), dim3(NTHR), LDS_BYTES, stream, a);
        const hipError_t le = hipPeekAtLastError();
        if (le != hipSuccess) { fprintf(stderr, "kernel_launch: launch %d failed: %s\n", li, hipGetErrorName(le)); break; }
    }
}
```

```cpp
#include <hip/hip_runtime.h>
#include <cstdio>
#include <cstdint>

#ifndef MK_N_LAUNCHES
#define MK_N_LAUNCHES 1
#endif

#define GAS __attribute__((address_space(1)))
#define LAS __attribute__((address_space(3)))
typedef unsigned short bf16;
typedef unsigned v4u __attribute__((ext_vector_type(4)));
typedef unsigned v2u __attribute__((ext_vector_type(2)));
typedef float f32x4 __attribute__((ext_vector_type(4)));
typedef float f32x2 __attribute__((ext_vector_type(2)));

constexpr int BATCH = 2, SEQ = 8192, DM = 1024, T = BATCH * SEQ;
constexpr int INW = 3088, NPJ = 3072;
constexpr int C_QG = 0, C_KG = 256, C_VG = 512, C_GG = 1024, C_QS = 1536, C_KS = 2048, C_VS = 2560;
constexpr int A_COL = 1536;
constexpr float ALPHA = 1.18920711500272f;
constexpr float EPS = 1e-5f;
constexpr int NWAVES = 8, NTHR = 512;
constexpr int NPHASE = 10;
constexpr float SB_EXIT_NAT = 30.0f;

constexpr size_t MiB = 1u << 20;
constexpr size_t WS_CTL = 0, CTL_ZERO_BYTES = 1 * MiB;
constexpr size_t WS_WTIN = 1 * MiB;
constexpr size_t WS_WTOUT = 7 * MiB;
constexpr size_t WS_WTQ = 9 * MiB;
constexpr size_t WS_SKB = 13 * MiB;
constexpr size_t WS_UB = 14 * MiB;
constexpr size_t WS_VB = 46 * MiB;
constexpr size_t WS_U8 = 14 * MiB;
constexpr size_t WS_V8 = 30 * MiB;
constexpr size_t WS_RSU = 46 * MiB;
constexpr size_t WS_RSV = 46 * MiB + 65536;
constexpr size_t WS_PROJ = 78 * MiB;
constexpr size_t WS_X1 = 78 * MiB, WS_X1B = 142 * MiB;
constexpr size_t WS_XB = 174 * MiB;
constexpr size_t WS_QRY = 174 * MiB;
constexpr size_t WS_CAT = 206 * MiB;
constexpr size_t WS_ST = 238 * MiB;
constexpr size_t WS_PIDX = 238 * MiB, WS_PGATE = 246 * MiB;
constexpr size_t WS_ALPHA = 238 * MiB;
constexpr size_t WS_SLOC = 174 * MiB;
constexpr size_t WS_DEC = 254 * MiB;
constexpr size_t WS_END = 255 * MiB + 512 * 1024;

constexpr int CW_BAR = 4096;

constexpr int LDS_BYTES = 147456;
constexpr int MISC_OFF = 140 * 1024;

__device__ __forceinline__ float bf2f(unsigned v) { return __uint_as_float(v << 16); }
__device__ __forceinline__ unsigned f2bf(float f) { unsigned u = __float_as_uint(f); return (u + 0x7fffu + ((u >> 16) & 1u)) >> 16; }
__device__ __forceinline__ unsigned pk2(float lo, float hi) { return f2bf(lo) | (f2bf(hi) << 16); }
__device__ __forceinline__ float wave_sum(float v) {
#pragma unroll
    for (int o = 1; o < 64; o <<= 1) v += __shfl_xor(v, o);
    return v;
}
__device__ __forceinline__ float logsig_neg(float z) {
    return -(fmaxf(z, 0.f) + log1pf(expf(-fabsf(z))));
}

#define XB_TMO      128
#define XB_XCNT(j)  (256  + 64 * (j))
#define XB_XSUB(j)  (1280 + 64 * (j))
#define XB_XGEN(j)  (2304 + 64 * (j))
#define XB_TOP      3328
#define XB_TOPGEN   3392
#define XCD_BAR_WORDS 3456
#define XB_SPIN_CAP (1u << 23)
__device__ __forceinline__ unsigned xb_ld(unsigned* p)              { return __hip_atomic_load(p, __ATOMIC_RELAXED, __HIP_MEMORY_SCOPE_AGENT); }
__device__ __forceinline__ unsigned xb_add(unsigned* p, unsigned v) { return __hip_atomic_fetch_add(p, v, __ATOMIC_RELAXED, __HIP_MEMORY_SCOPE_AGENT); }
__device__ __forceinline__ unsigned xb_xcc_id() { return (unsigned)__builtin_amdgcn_s_getreg((3 << 11) | 20) & 0xFu; }
#define XB_SPIN(cond, bar) do { unsigned _sp = 0; while (cond) { __builtin_amdgcn_s_sleep(1); \
    if ((++_sp & 255u) == 0u) { if (xb_ld(&(bar)[XB_TMO])) break; if (_sp > XB_SPIN_CAP) { atomicAdd(&(bar)[XB_TMO], 1u); break; } } } } while (0)
struct XcdBarrier { unsigned* bar; unsigned x; volatile LAS unsigned* st; };
__device__ __forceinline__ XcdBarrier xcd_barrier_post(unsigned* bar, volatile LAS unsigned* st) {
    XcdBarrier b; b.bar = bar; b.x = xb_xcc_id(); b.st = st;
    if (threadIdx.x == 0) (void)xb_add(&bar[XB_XCNT(b.x)], 1u);
    return b;
}
__device__ __forceinline__ void xcd_barrier_complete(unsigned* bar, unsigned x, unsigned& nloc, unsigned& nx) {
    const unsigned G = gridDim.x * gridDim.y * gridDim.z;
    unsigned sum, cnt, mine, sp = 0u;
    for (;;) {
        sum = 0u; cnt = 0u; mine = 0u;
#pragma unroll
        for (unsigned j = 0; j < 16; ++j) { const unsigned c = xb_ld(&bar[XB_XCNT(j)]); sum += c; cnt += (c > 0u) ? 1u : 0u; mine = (j == x) ? c : mine; }
        if (sum == G) break;
        __builtin_amdgcn_s_sleep(1);
        if ((++sp & 255u) == 0u) { if (xb_ld(&bar[XB_TMO])) break; if (sp > XB_SPIN_CAP) { atomicAdd(&bar[XB_TMO], 1u); break; } }
    }
    nloc = mine > 0u ? mine : 1u; nx = cnt > 0u ? cnt : 1u;
}
__device__ __forceinline__ void xcd_barrier(const XcdBarrier& b) {
    asm volatile("s_waitcnt vmcnt(0)" ::: "memory");
    __syncthreads();
    if (threadIdx.x == 0) {
        unsigned* bar = b.bar;
        __builtin_amdgcn_s_waitcnt(0);
        unsigned nloc = b.st[0], nx = b.st[1];
        if (nloc == 0u) { xcd_barrier_complete(bar, b.x, nloc, nx); b.st[0] = nloc; b.st[1] = nx; }
        const unsigned old = xb_add(&bar[XB_XSUB(b.x)], 1u);
        const unsigned gen = old / nloc;
        if (old + 1u == (gen + 1u) * nloc) {
            __builtin_amdgcn_fence(__ATOMIC_RELEASE, "agent");
            asm volatile("s_waitcnt vmcnt(0)" ::: "memory");
            const unsigned og = xb_add(&bar[XB_TOP], 1u);
            const unsigned tg = og / nx;
            if (og + 1u == (tg + 1u) * nx) xb_add(&bar[XB_TOPGEN], 1u);
            else XB_SPIN(xb_ld(&bar[XB_TOPGEN]) == tg, bar);
            __builtin_amdgcn_fence(__ATOMIC_ACQUIRE, "agent");
            xb_add(&bar[XB_XGEN(b.x)], 1u);
            asm volatile("s_waitcnt vmcnt(0)" ::: "memory");
        } else {
            XB_SPIN(xb_ld(&bar[XB_XGEN(b.x)]) == gen, bar);
            __builtin_amdgcn_fence(__ATOMIC_ACQUIRE, "agent");
            asm volatile("s_waitcnt vmcnt(0)" ::: "memory");
        }
    }
    __syncthreads();
}

namespace pg8 {
#define PG8_LAS __attribute__((address_space(3)))
typedef unsigned short bf16_t;
typedef short bf16x8 __attribute__((ext_vector_type(8)));
typedef float f32x4 __attribute__((ext_vector_type(4)));
typedef unsigned u32x4 __attribute__((ext_vector_type(4)));
constexpr int BM = 256, BK = 64, HALF = 128, HTB = HALF * BK * 2  , STAGE_BYTES = 8 * HTB, NXCD = 8, WGM = 8;

__host__ __device__ __forceinline__ int lds_byte(int r, int c) { const int st = (r >> 4) * 2 + (c >> 5), rr = r & 15, cc = c & 31, ob = rr * 64 + cc * 2; return st * 1024 + (ob ^ (((ob >> 9) & 1) << 5)); }
__host__ __device__ __forceinline__ void stage_rc(int b, int& R, int& C) { const int st = b / 1024, sb = b % 1024, swz = sb ^ (((sb >> 9) & 1) << 5); R = (st >> 1) * 16 + swz / 64; C = (st & 1) * 32 + (swz % 64) / 2; }
__host__ __device__ __forceinline__ int perm32(int rho) { const int n = rho >> 4, i = rho & 15; return 8 * (i >> 2) + 4 * n + (i & 3); }

struct Unit { int pm, pn; };
struct Gemm { const bf16_t* A; const bf16_t* Bt; int M, N, K; };

struct StaticOrder {
    int nM, nN, nwg, G, c;
    __host__ __device__ void init(int M, int N, int G_, int c_) { nM = M / BM; nN = N / BM; nwg = nM * nN; G = G_; c = c_; }
    __host__ __device__ bool next(int i, Unit& u) const {
        const long L = (long)i * G + c; if (L >= nwg) return false;
        int wgid = (int)L; { const int q = nwg / NXCD, r = nwg % NXCD, xcd = wgid % NXCD, off = wgid / NXCD; wgid = (xcd < r ? xcd * (q + 1) : r * (q + 1) + (xcd - r) * q) + off; }
        const int nig = WGM * nN, gid = wgid / nig, fm = gid * WGM, gsz = (nM - fm) < WGM ? (nM - fm) : WGM;
        u.pm = fm + ((wgid % nig) % gsz); u.pn = (wgid % nig) / gsz; return true;
    }
    __device__ __forceinline__ void a_ready(const Unit&) const {}
    __device__ __forceinline__ void done(const Unit&) const {}
};

__device__ __forceinline__ unsigned cvt_pk_bf16(float lo, float hi) { unsigned r; asm volatile("v_cvt_pk_bf16_f32 %0, %1, %2" : "=v"(r) : "v"(lo), "v"(hi)); return r; }
typedef float f32x2 __attribute__((ext_vector_type(2)));
__device__ __forceinline__ f32x2 gelu_pk(f32x2 v) {
    const f32x2 av = __builtin_elementwise_abs(v), d = av * 0.2316418882f + 1.0f;
    f32x2 t; t.x = __builtin_amdgcn_rcpf(d.x); t.y = __builtin_amdgcn_rcpf(d.y);
    f32x2 q = t * 0.5307027145f + (-0.7265760135f); q = q * t + 0.7107068705f; q = q * t + (-0.142248368f); q = q * t + 0.127414796f; q = q * t;
    const f32x2 s = (v * v) * (-0.72134752044f);
    f32x2 e; e.x = __builtin_amdgcn_exp2f(s.x); e.y = __builtin_amdgcn_exp2f(s.y);
    const f32x2 m = v * (q * e), r = v - m;
    f32x2 o; o.x = v.x < 0.f ? m.x : r.x; o.y = v.y < 0.f ? m.y : r.y; return o;
}

template <int ACT  > struct EpiBf16 {
    static constexpr bool PERM = true, AFTER_DRAIN = false; static_assert(ACT == 0 || ACT == 1, "EpiBf16: ACT is 0 (none) or 1 (gelu_pk)");
    bf16_t* O; int ldc; const float* bias; int split_cols; size_t split_stride; float scale0;
    __device__ __forceinline__ void operator()(const f32x4 (&acc)[2][2][4][2], const Unit& u, int wr, int wc, int fr, int fq) const {
        const int row0 = u.pm * BM + wr * 64 + fr; int colt = u.pn * BM; bf16_t* base = O;
        float sc = 1.f; if (split_cols) { const int t = colt / split_cols; base += (size_t)t * split_stride; colt -= t * split_cols; if (t == 0) sc = scale0; }
        const int col0 = colt + wc * 32 + 8 * fq, bcol0 = u.pn * BM + wc * 32 + 8 * fq;
        f32x4 bv[2][2];
#pragma unroll
        for (int bj = 0; bj < 2; ++bj)
#pragma unroll
            for (int n = 0; n < 2; ++n) bv[bj][n] = bias ? *(const f32x4*)(bias + bcol0 + bj * HALF + 4 * n) : (f32x4){0.f, 0.f, 0.f, 0.f};
#pragma unroll
        for (int ai = 0; ai < 2; ++ai)
#pragma unroll
            for (int m = 0; m < 4; ++m) { bf16_t* rowp = base + (size_t)(row0 + ai * HALF + m * 16) * ldc + col0;
#pragma unroll
                for (int bj = 0; bj < 2; ++bj) { f32x4 v0 = acc[ai][bj][m][0] + bv[bj][0], v1 = acc[ai][bj][m][1] + bv[bj][1];
                    if (ACT == 1) { f32x2 a = gelu_pk((f32x2){v0[0], v0[1]}), b = gelu_pk((f32x2){v0[2], v0[3]}), c = gelu_pk((f32x2){v1[0], v1[1]}), d = gelu_pk((f32x2){v1[2], v1[3]});
                        v0 = (f32x4){a.x, a.y, b.x, b.y}; v1 = (f32x4){c.x, c.y, d.x, d.y}; }
                    v0 = v0 * sc; v1 = v1 * sc; u32x4 w; w.x = cvt_pk_bf16(v0[0], v0[1]); w.y = cvt_pk_bf16(v0[2], v0[3]); w.z = cvt_pk_bf16(v1[0], v1[1]); w.w = cvt_pk_bf16(v1[2], v1[3]);
                    *(u32x4*)(rowp + bj * HALF) = w; } }
    }
};

struct EpiF32 {
    static constexpr bool PERM = true, AFTER_DRAIN = false;
    float* O; int ldc;
    __device__ __forceinline__ void operator()(const f32x4 (&acc)[2][2][4][2], const Unit& u, int wr, int wc, int fr, int fq) const {
        const int row0 = u.pm * BM + wr * 64 + fr, col0 = u.pn * BM + wc * 32 + 8 * fq;
#pragma unroll
        for (int ai = 0; ai < 2; ++ai)
#pragma unroll
            for (int m = 0; m < 4; ++m) { float* rowp = O + (size_t)(row0 + ai * HALF + m * 16) * ldc + col0;
#pragma unroll
                for (int bj = 0; bj < 2; ++bj) { *(f32x4*)(rowp + bj * HALF) = acc[ai][bj][m][0]; *(f32x4*)(rowp + bj * HALF + 4) = acc[ai][bj][m][1]; } }
    }
};
template <class Epi, class Sched, bool ALIGN_EPI = false, bool SP2 = false>
__device__ __forceinline__ void gemm_phase(PG8_LAS unsigned char* lds, const Gemm g, const Sched& S, const Epi& E) {
    const int tid = threadIdx.x, wid = __builtin_amdgcn_readfirstlane(tid >> 6), lane = tid & 63, wr = wid >> 2, wc = wid & 3, fr = lane & 15, fq = lane >> 4;
    const int K = g.K, nt = K / BK;
    unsigned voffA[2], voffB[2];
#pragma unroll
    for (int i = 0; i < 2; ++i) { int R, C; stage_rc(tid * 16 + i * 8192, R, C); const int Rb = Epi::PERM ? ((R & ~31) + perm32(R & 31)) : R;
        voffA[i] = (unsigned)(R * K + C) * 2u; voffB[i] = (unsigned)(Rb * K + C) * 2u; }
    const size_t kstep = (size_t)(BK * 2);
    const size_t hstep = (size_t)HALF * K * 2;
    const size_t tstep = 2 * hstep;
    const unsigned ldsw = (unsigned)wid * 1024u;
    const int aoff = lds_byte(wr * 64 + fr, fq * 8), boff = lds_byte(wc * 32 + fr, fq * 8);
#define PG8_SA(b, h) (((b) * 2 + (h)) * HTB)
#define PG8_SB(b, h) ((4 + (b) * 2 + (h)) * HTB)
#define PG8_STAGE(bufoff, gbase, voff) do { _Pragma("unroll") for (int _i = 0; _i < 2; ++_i) \
        __builtin_amdgcn_global_load_lds((const unsigned*)((const char*)(gbase) + (voff)[_i]), (PG8_LAS unsigned*)(lds + (bufoff) + ldsw + _i * 8192), 16, 0, 0); } while (0)
#define PG8_LDA(dst, b, h) do { _Pragma("unroll") for (int m = 0; m < 4; ++m) _Pragma("unroll") for (int k = 0; k < 2; ++k) dst[m][k] = *(const PG8_LAS bf16x8*)(lds + PG8_SA(b, h) + aoff + m * 2048 + k * 1024); } while (0)
#define PG8_LDB(dst, b, h) do { _Pragma("unroll") for (int n = 0; n < 2; ++n) _Pragma("unroll") for (int k = 0; k < 2; ++k) dst[n][k] = *(const PG8_LAS bf16x8*)(lds + PG8_SB(b, h) + boff + n * 2048 + k * 1024); } while (0)
#define PG8_MMA(ai, bj, At, Bt) do { __builtin_amdgcn_s_setprio(1); _Pragma("unroll") for (int m = 0; m < 4; ++m) _Pragma("unroll") for (int n = 0; n < 2; ++n) _Pragma("unroll") for (int k = 0; k < 2; ++k) \
        acc[ai][bj][m][n] = __builtin_amdgcn_mfma_f32_16x16x32_bf16(Bt[n][k], At[m][k], acc[ai][bj][m][n], 0, 0, 0); __builtin_amdgcn_s_setprio(0); } while (0)
#define PG8_WAIT_V(n) asm volatile("s_waitcnt vmcnt(" #n ")" ::: "memory")
#define PG8_WAIT_L(n) asm volatile("s_waitcnt lgkmcnt(" #n ")" ::: "memory")
#define PG8_BAR __builtin_amdgcn_s_barrier()
#define PG8_SCHED __builtin_amdgcn_sched_barrier(0)
    Unit cur, nxt; int ui = 0;
    if (!S.next(0, cur)) return;
    f32x4 acc[2][2][4][2];
#pragma unroll
    for (int a = 0; a < 2; ++a)
#pragma unroll
        for (int b = 0; b < 2; ++b)
#pragma unroll
            for (int m = 0; m < 4; ++m)
#pragma unroll
                for (int n = 0; n < 2; ++n) acc[a][b][m][n] = (f32x4){0.f, 0.f, 0.f, 0.f};
    bf16x8 At[4][2], B0[2][2], B1[2][2];
    const char* cA = (const char*)g.A + (size_t)cur.pm * tstep; const char* cB = (const char*)g.Bt + (size_t)cur.pn * tstep;
    S.a_ready(cur);
    if constexpr (SP2) {
        PG8_STAGE(PG8_SB(0, 0), cB, voffB); PG8_STAGE(PG8_SB(0, 1), cB + hstep, voffB); PG8_STAGE(PG8_SA(0, 0), cA, voffA); PG8_STAGE(PG8_SA(0, 1), cA + hstep, voffA);
        if (wr == 1) PG8_BAR;
        PG8_WAIT_V(2); PG8_BAR;
        PG8_STAGE(PG8_SB(1, 0), cB + kstep, voffB); PG8_STAGE(PG8_SA(1, 0), cA + kstep, voffA); PG8_STAGE(PG8_SB(1, 1), cB + hstep + kstep, voffB);
        PG8_WAIT_V(6); PG8_BAR;
    } else {
        PG8_STAGE(PG8_SB(0, 0), cB, voffB); PG8_STAGE(PG8_SA(0, 0), cA, voffA); PG8_STAGE(PG8_SB(0, 1), cB + hstep, voffB); PG8_STAGE(PG8_SA(0, 1), cA + hstep, voffA);
        if (wr == 1) PG8_BAR;
        PG8_WAIT_V(4); PG8_BAR;
        PG8_STAGE(PG8_SB(1, 0), cB + kstep, voffB); PG8_STAGE(PG8_SA(1, 0), cA + kstep, voffA); PG8_STAGE(PG8_SB(1, 1), cB + hstep + kstep, voffB);
        PG8_WAIT_V(6); PG8_BAR;
    }
    for (;;) {
        const bool has_next = S.next(ui + 1, nxt);
        const char* nA = has_next ? (const char*)g.A + (size_t)nxt.pm * tstep : cA; const char* nB = has_next ? (const char*)g.Bt + (size_t)nxt.pn * tstep : cB;
        for (int t = 0; t < nt; t += 2) {
            const bool last = (t == nt - 2);
            const char* a1 = cA + (size_t)(t + 1) * kstep;
            const char* a2 = last ? nA : cA + (size_t)(t + 2) * kstep; const char* b2 = last ? nB : cB + (size_t)(t + 2) * kstep;
            const char* a3 = a2 + kstep; const char* b3 = b2 + kstep;
            if (last && has_next) S.a_ready(nxt);
            if constexpr (SP2) {
            PG8_LDB(B0, 0, 0); PG8_LDB(B1, 0, 1); PG8_SCHED; PG8_LDA(At, 0, 0); PG8_STAGE(PG8_SA(1, 1), a1 + hstep, voffA);
            PG8_WAIT_V(8); PG8_WAIT_L(0); PG8_BAR; PG8_MMA(0, 0, At, B0); PG8_MMA(0, 1, At, B1); PG8_BAR; PG8_SCHED;
            PG8_LDA(At, 0, 1); PG8_STAGE(PG8_SB(0, 0), b2, voffB); PG8_STAGE(PG8_SB(0, 1), b2 + hstep, voffB); PG8_STAGE(PG8_SA(0, 0), a2, voffA);
            PG8_WAIT_V(8); PG8_WAIT_L(0); PG8_BAR; PG8_MMA(1, 0, At, B0); PG8_MMA(1, 1, At, B1); PG8_BAR; PG8_SCHED;
            PG8_LDB(B0, 1, 0); PG8_LDB(B1, 1, 1); PG8_SCHED; PG8_LDA(At, 1, 0); PG8_STAGE(PG8_SA(0, 1), a2 + hstep, voffA);
            PG8_WAIT_V(8); PG8_WAIT_L(0); PG8_BAR; PG8_MMA(0, 0, At, B0); PG8_MMA(0, 1, At, B1); PG8_BAR; PG8_SCHED;
            PG8_LDA(At, 1, 1); PG8_STAGE(PG8_SB(1, 0), b3, voffB); PG8_STAGE(PG8_SB(1, 1), b3 + hstep, voffB); PG8_STAGE(PG8_SA(1, 0), a3, voffA);
            PG8_WAIT_V(8); PG8_WAIT_L(0); PG8_BAR; PG8_MMA(1, 0, At, B0); PG8_MMA(1, 1, At, B1); PG8_BAR; PG8_SCHED;
            } else {
            PG8_LDB(B0, 0, 0); PG8_SCHED; PG8_LDA(At, 0, 0); PG8_STAGE(PG8_SA(1, 1), a1 + hstep, voffA);
            PG8_WAIT_L(8); PG8_BAR; PG8_WAIT_L(0); PG8_MMA(0, 0, At, B0); PG8_BAR; PG8_SCHED;
            PG8_LDB(B1, 0, 1); PG8_STAGE(PG8_SB(0, 0), b2, voffB);
            PG8_BAR; PG8_WAIT_L(0); PG8_MMA(0, 1, At, B1); PG8_BAR;
            PG8_LDA(At, 0, 1); PG8_STAGE(PG8_SA(0, 0), a2, voffA);
            PG8_BAR; PG8_WAIT_L(0); PG8_MMA(1, 0, At, B0); PG8_BAR; PG8_SCHED;
            PG8_STAGE(PG8_SB(0, 1), b2 + hstep, voffB);
            PG8_WAIT_V(6); PG8_BAR; PG8_MMA(1, 1, At, B1); PG8_BAR;
            PG8_LDB(B0, 1, 0); PG8_SCHED; PG8_LDA(At, 1, 0); PG8_STAGE(PG8_SA(0, 1), a2 + hstep, voffA);
            PG8_WAIT_L(8); PG8_BAR; PG8_WAIT_L(0); PG8_MMA(0, 0, At, B0); PG8_BAR; PG8_SCHED;
            PG8_LDB(B1, 1, 1); PG8_STAGE(PG8_SB(1, 0), b3, voffB);
            PG8_BAR; PG8_WAIT_L(0); PG8_MMA(0, 1, At, B1); PG8_BAR;
            PG8_LDA(At, 1, 1); PG8_STAGE(PG8_SA(1, 0), a3, voffA);
            PG8_BAR; PG8_WAIT_L(0); PG8_MMA(1, 0, At, B0); PG8_BAR; PG8_SCHED;
            PG8_STAGE(PG8_SB(1, 1), b3 + hstep, voffB);
            PG8_WAIT_V(6); PG8_BAR; PG8_MMA(1, 1, At, B1); PG8_BAR;
            }
        }
        if constexpr (ALIGN_EPI) { if (wr == 0) PG8_BAR; }
        if constexpr (!Epi::AFTER_DRAIN) { E(acc, cur, wr, wc, fr, fq); S.done(cur); }
        if (!has_next) break;
#pragma unroll
        for (int a = 0; a < 2; ++a)
#pragma unroll
            for (int b = 0; b < 2; ++b)
#pragma unroll
                for (int m = 0; m < 4; ++m)
#pragma unroll
                    for (int n = 0; n < 2; ++n) acc[a][b][m][n] = (f32x4){0.f, 0.f, 0.f, 0.f};
        cur = nxt; cA = nA; cB = nB; ++ui;
        if constexpr (ALIGN_EPI) { if (wr == 1) PG8_BAR; }
    }
    PG8_WAIT_V(0);
    if constexpr (!ALIGN_EPI) { if (wr == 0) PG8_BAR; }
    PG8_BAR;
    if constexpr (Epi::AFTER_DRAIN) { E.fused(acc, cur, wr, wc, fr, fq, lds, wid, lane); S.done(cur); }
#undef PG8_SA
#undef PG8_SB
#undef PG8_STAGE
#undef PG8_LDA
#undef PG8_LDB
#undef PG8_MMA
#undef PG8_WAIT_V
#undef PG8_WAIT_L
#undef PG8_BAR
#undef PG8_SCHED
}
}

struct Frame {
    unsigned char* lds;
    int tid, lane, wave, vcu, G;
    const float *x, *w_in, *w_gate, *b_gate, *gla_g, *sb_g, *w_out, *ln1_g, *ln1_b, *w_q, *sub_keys, *pu, *pv, *ln2_g, *ln2_b;
    float* out;
    unsigned char* ws;
};
#define WSP(type, off) ((type*)(F.ws + (off)))

__device__ __forceinline__ void p0_transpose_item(const float* W, int K, int ldw, int c0, int ncols, bf16* WT, int row_off, float* scr, int item, int lane) {
    const int nblk = ncols / 32, kb = item / nblk, nb = item % nblk, k0 = 64 * kb, n0 = 32 * nb;
#pragma unroll 8
    for (int i = 0; i < 32; ++i) { const int kk = 2 * i + (lane >> 5); scr[kk * 33 + (lane & 31)] = W[(size_t)(k0 + kk) * ldw + c0 + n0 + (lane & 31)]; }
    asm volatile("s_waitcnt lgkmcnt(0)" ::: "memory");
    const int c = lane & 7;
#pragma unroll
    for (int j = 0; j < 4; ++j) { const int n = (lane >> 3) + 8 * j; const float* s = scr + (8 * c) * 33 + n;
        v4u o; o.x = pk2(s[0 * 33], s[1 * 33]); o.y = pk2(s[2 * 33], s[3 * 33]); o.z = pk2(s[4 * 33], s[5 * 33]); o.w = pk2(s[6 * 33], s[7 * 33]);
        *(v4u*)(WT + (size_t)(row_off + n0 + n) * K + k0 + 8 * c) = o; }
    asm volatile("s_waitcnt lgkmcnt(0)" ::: "memory");
}
__device__ __forceinline__ void cvt_f32_bf16_bulk(Frame& F, const float* src, bf16* dst, size_t n8) {
    const size_t gt = (size_t)F.vcu * NTHR + F.tid, NT = (size_t)F.G * NTHR;
    for (size_t i = gt; i < n8; i += NT) {
        const f32x4 a = *(const f32x4*)(src + i * 8), b = *(const f32x4*)(src + i * 8 + 4);
        v4u o; o.x = pk2(a.x, a.y); o.y = pk2(a.z, a.w); o.z = pk2(b.x, b.y); o.w = pk2(b.z, b.w);
        *(v4u*)(dst + i * 8) = o;
    }
}
__device__ __forceinline__ void ph0_prologue(Frame& F) {
    float* wa = (float*)F.lds;
    float* scr = (float*)(F.lds + 65536 + F.wave * 8448);
    const int gw = F.vcu * NWAVES + F.wave, NGW = F.G * NWAVES;
    for (int idx = F.tid; idx < 16384; idx += NTHR) { const int k = idx >> 4, r = idx & 15; wa[r * 1024 + k] = F.w_in[(size_t)k * INW + A_COL + r]; }
    constexpr int I_IN1 = 16 * 48, I_IN2 = 16 * 48, I_OUT = 16 * 32, I_Q = 16 * 64, NITEMS = I_IN1 + I_IN2 + I_OUT + I_Q;
    for (int it = gw; it < NITEMS; it += NGW) {
        int r = it;
        if (r < I_IN1) { p0_transpose_item(F.w_in, 1024, INW, 0, 1536, WSP(bf16, WS_WTIN), 0, scr, r, F.lane); continue; } r -= I_IN1;
        if (r < I_IN2) { p0_transpose_item(F.w_in, 1024, INW, 1552, 1536, WSP(bf16, WS_WTIN), 1536, scr, r, F.lane); continue; } r -= I_IN2;
        if (r < I_OUT) { p0_transpose_item(F.w_out, 1024, 1024, 0, 1024, WSP(bf16, WS_WTOUT), 0, scr, r, F.lane); continue; } r -= I_OUT;
        p0_transpose_item(F.w_q, 1024, 2048, 0, 2048, WSP(bf16, WS_WTQ), 0, scr, r, F.lane);
    }
    cvt_f32_bf16_bulk(F, F.sub_keys, WSP(bf16, WS_SKB), (size_t)8 * 2 * 128 * 128 / 8);
    for (int it = gw; it < 2 * 16384; it += NGW) {
        const int tb = it >> 14, e = it & 16383; const float* src = (tb ? F.pv : F.pu) + (size_t)e * DM + 16 * F.lane;
        f32x4 a[4]; float mx = 0.f;
#pragma unroll
        for (int j = 0; j < 4; ++j) { a[j] = *(const f32x4*)(src + 4 * j); mx = fmaxf(mx, fmaxf(fmaxf(fabsf(a[j].x), fabsf(a[j].y)), fmaxf(fabsf(a[j].z), fabsf(a[j].w)))); }
#pragma unroll
        for (int o = 1; o < 64; o <<= 1) mx = fmaxf(mx, __shfl_xor(mx, o));
        const float sc = (mx > 0.f) ? 384.0f / mx : 1.0f;
        v4u q;
#pragma unroll
        for (int j = 0; j < 4; ++j) { int w = __builtin_amdgcn_cvt_pk_fp8_f32(a[j].x * sc, a[j].y * sc, 0, false); w = __builtin_amdgcn_cvt_pk_fp8_f32(a[j].z * sc, a[j].w * sc, w, true); q[j] = (unsigned)w; }
        *(v4u*)(F.ws + (tb ? WS_V8 : WS_U8) + (size_t)e * DM + 16 * F.lane) = q;
        if (F.lane == 0) WSP(float, tb ? WS_RSV : WS_RSU)[e] = 1.0f / sc;
    }
    __syncthreads();
    bf16* xb = WSP(bf16, WS_XB); float* alpha = WSP(float, WS_ALPHA);
    float wgr[16][4], bgr[4];
#pragma unroll
    for (int i = 0; i < 4; ++i) { bgr[i] = F.b_gate[F.lane + 64 * i];
#pragma unroll
        for (int r = 0; r < 16; ++r) wgr[r][i] = F.w_gate[r * 256 + F.lane + 64 * i]; }
    for (int m = gw; m < T; m += NGW) {
        const float* xr = F.x + (size_t)m * DM;
        f32x4 xv[4];
#pragma unroll
        for (int i = 0; i < 4; ++i) { xv[i] = *(const f32x4*)(xr + 256 * i + 4 * F.lane);
            v2u o; o.x = pk2(xv[i].x, xv[i].y); o.y = pk2(xv[i].z, xv[i].w); *(v2u*)(xb + (size_t)m * DM + 256 * i + 4 * F.lane) = o; }
        float sg[4] = {bgr[0], bgr[1], bgr[2], bgr[3]};
#pragma unroll
        for (int r = 0; r < 16; ++r) {
            float a = 0.f;
#pragma unroll
            for (int i = 0; i < 4; ++i) { const f32x4 w = *(const f32x4*)(wa + r * 1024 + 256 * i + 4 * F.lane); a += xv[i].x * w.x + xv[i].y * w.y + xv[i].z * w.z + xv[i].w * w.w; }
            a = wave_sum(a);
#pragma unroll
            for (int i = 0; i < 4; ++i) sg[i] += a * wgr[r][i];
            asm volatile("" ::: "memory");
        }
#pragma unroll
        for (int i = 0; i < 4; ++i) { const float la = -(fmaxf(-sg[i], 0.f) + log1pf(expf(-fabsf(sg[i])))) * (1.0f / 16.0f);
            alpha[(size_t)m * 256 + F.lane + 64 * i] = expf(la); }
    }
}

struct EpiBf16Store { bf16* C; int ldc;
    __device__ __forceinline__ void operator()(int row, int col, const float (&acc)[8][4]) const {
#pragma unroll
        for (int i = 0; i < 8; ++i) { v2u o; o.x = pk2(acc[i][0], acc[i][1]); o.y = pk2(acc[i][2], acc[i][3]); *(v2u*)(C + (size_t)(row + i) * ldc + col) = o; } } };
struct EpiF32Store { float* C; int ldc;
    __device__ __forceinline__ void operator()(int row, int col, const float (&acc)[8][4]) const {
#pragma unroll
        for (int i = 0; i < 8; ++i) *(f32x4*)(C + (size_t)(row + i) * ldc + col) = (f32x4){acc[i][0], acc[i][1], acc[i][2], acc[i][3]}; } };
template <class Epi>
__device__ __forceinline__ void naive_gemm(Frame& F, const bf16* A, const bf16* Bt, int M, int N, int K, const Epi& epi) {
    float* As = (float*)F.lds; float* Bs = As + 32 * 132;
    const int tid = F.tid, tm = tid >> 5, tn = tid & 31, lr = tid >> 2, lk = (tid & 3) * 8;
    const int nN = N / 128, nU = (M / 128) * nN;
    for (int u = F.vcu; u < nU; u += F.G) {
        const int pm = u / nN, pn = u % nN;
        float acc[8][4];
#pragma unroll
        for (int i = 0; i < 8; ++i)
#pragma unroll
            for (int j = 0; j < 4; ++j) acc[i][j] = 0.f;
        const bf16* ap = A + (size_t)(pm * 128 + lr) * K + lk; const bf16* bp = Bt + (size_t)(pn * 128 + lr) * K + lk;
        for (int k0 = 0; k0 < K; k0 += 32) {
            const v4u av = *(const v4u*)(ap + k0), bv = *(const v4u*)(bp + k0);
            __syncthreads();
#pragma unroll
            for (int j = 0; j < 4; ++j) {
                As[(lk + 2 * j) * 132 + lr] = __uint_as_float(av[j] << 16); As[(lk + 2 * j + 1) * 132 + lr] = __uint_as_float(av[j] & 0xffff0000u);
                Bs[(lk + 2 * j) * 132 + lr] = __uint_as_float(bv[j] << 16); Bs[(lk + 2 * j + 1) * 132 + lr] = __uint_as_float(bv[j] & 0xffff0000u); }
            __syncthreads();
#pragma unroll 4
            for (int k = 0; k < 32; ++k) {
                const f32x4 a0 = *(const f32x4*)(As + k * 132 + tm * 8), a1 = *(const f32x4*)(As + k * 132 + tm * 8 + 4), b = *(const f32x4*)(Bs + k * 132 + tn * 4);
                const float a[8] = {a0.x, a0.y, a0.z, a0.w, a1.x, a1.y, a1.z, a1.w}; const float bb[4] = {b.x, b.y, b.z, b.w};
#pragma unroll
                for (int i = 0; i < 8; ++i)
#pragma unroll
                    for (int j = 0; j < 4; ++j) acc[i][j] += a[i] * bb[j];
            }
        }
        epi(pm * 128 + tm * 8, pn * 128 + tn * 4, acc);
    }
    __syncthreads();
}

template <bool OUT>
__device__ __forceinline__ void gla_chunk_pass(Frame& F) {
    const bf16* proj = WSP(bf16, WS_PROJ); const float* alpha = WSP(float, WS_ALPHA); bf16* cat = WSP(bf16, WS_CAT);
    float* sloc = WSP(float, WS_SLOC); float* dec = WSP(float, WS_DEC);
    float* qs = (float*)F.lds; float* ks = qs + 4096; float* as = ks + 4096; float* os = as + 4096;
    const int tid = F.tid, lane = F.lane, e = 16 * F.wave + (lane & 15), cg = lane >> 4;
    for (int u = F.vcu; u < 1024; u += F.G) {
        const int bh = u >> 7, ch = u & 127, b = bh >> 2, h = bh & 3; const size_t row0 = (size_t)b * SEQ + ch * 64;
        __syncthreads();
        for (int i = tid; i < 4096; i += NTHR) { const int tt = i >> 6, c = i & 63; const size_t row = row0 + tt;
            if (OUT) qs[i] = bf2f(proj[row * NPJ + C_QG + h * 64 + c]) * 0.125f;
            ks[i] = bf2f(proj[row * NPJ + C_KG + h * 64 + c]);
            as[i] = alpha[row * 256 + h * 64 + c]; }
        float S[16];
#pragma unroll
        for (int i = 0; i < 16; ++i) S[i] = OUT ? sloc[(size_t)u * 8192 + (16 * cg + i) * 128 + e] : 0.f;
        __syncthreads();
        if (!OUT) {
            for (int tt = 0; tt < 64; ++tt) { const float v = bf2f(proj[(row0 + tt) * NPJ + C_VG + h * 128 + e]);
#pragma unroll
                for (int i = 0; i < 16; ++i) S[i] = S[i] * as[tt * 64 + 16 * cg + i] + ks[tt * 64 + 16 * cg + i] * v; }
#pragma unroll
            for (int i = 0; i < 16; ++i) sloc[(size_t)u * 8192 + (16 * cg + i) * 128 + e] = S[i];
            if (tid < 64) { float d = 1.f; for (int tt = 0; tt < 64; ++tt) d *= as[tt * 64 + tid]; dec[(size_t)u * 64 + tid] = d; }
        } else {
            for (int t0 = 0; t0 < 64; t0 += 16) {
                for (int tt = t0; tt < t0 + 16; ++tt) { const float v = bf2f(proj[(row0 + tt) * NPJ + C_VG + h * 128 + e]); float o = 0.f;
#pragma unroll
                    for (int i = 0; i < 16; ++i) { S[i] = S[i] * as[tt * 64 + 16 * cg + i] + ks[tt * 64 + 16 * cg + i] * v; o += qs[tt * 64 + 16 * cg + i] * S[i]; }
                    o += __shfl_xor(o, 16); o += __shfl_xor(o, 32);
                    if (cg == 0) os[(tt - t0) * 128 + e] = o; }
                __syncthreads();
#pragma unroll
                for (int j = 0; j < 2; ++j) { const int tt = F.wave * 2 + j; const size_t row = row0 + t0 + tt;
                    const float o0 = os[tt * 128 + lane], o1 = os[tt * 128 + 64 + lane];
                    const float ss = wave_sum(o0 * o0 + o1 * o1); const float r = rsqrtf(ss * (1.0f / 128.0f) + EPS);
                    const float g0 = bf2f(proj[row * NPJ + C_GG + h * 128 + lane]), g1 = bf2f(proj[row * NPJ + C_GG + h * 128 + 64 + lane]);
                    const float y0 = o0 * r * F.gla_g[h * 128 + lane] * (g0 / (1.f + expf(-g0)));
                    const float y1 = o1 * r * F.gla_g[h * 128 + 64 + lane] * (g1 / (1.f + expf(-g1)));
                    cat[row * DM + h * 128 + lane] = (bf16)f2bf(y0); cat[row * DM + h * 128 + 64 + lane] = (bf16)f2bf(y1); }
                __syncthreads();
            }
        }
    }
    __syncthreads();
}
__device__ __forceinline__ void gla_scan(Frame& F) {
    float* sloc = WSP(float, WS_SLOC); const float* dec = WSP(float, WS_DEC);
    const int g = F.vcu * NTHR + F.tid;
    if (g >= 65536) return;
    const int bh = g >> 13, ce = g & 8191, c = ce >> 7;
    float* sp = sloc + (size_t)bh * 128 * 8192 + ce; const float* dp = dec + (size_t)bh * 128 * 64 + c;
    float S = 0.f; float v[8], d[8];
#pragma unroll
    for (int j = 0; j < 8; ++j) { v[j] = sp[(size_t)j * 8192]; d[j] = dp[j * 64]; }
    for (int s0 = 0; s0 < 128; s0 += 8) {
        float vn[8], dn[8];
        const int s1 = (s0 + 8 < 128) ? s0 + 8 : s0;
#pragma unroll
        for (int j = 0; j < 8; ++j) { vn[j] = sp[(size_t)(s1 + j) * 8192]; dn[j] = dp[(s1 + j) * 64]; }
#pragma unroll
        for (int j = 0; j < 8; ++j) { sp[(size_t)(s0 + j) * 8192] = S; S = S * d[j] + v[j]; }
#pragma unroll
        for (int j = 0; j < 8; ++j) { v[j] = vn[j]; d[j] = dn[j]; }
    }
}
__device__ __forceinline__ void ph2_sb_naive(Frame& F) {
    const bf16* proj = WSP(bf16, WS_PROJ); bf16* cat = WSP(bf16, WS_CAT);
    float* Ks = (float*)F.lds; float* Vs = Ks + 32 * 64;
    const int tid = F.tid;
    for (int u = F.vcu; u < 256; u += F.G) {
        const int bh = u >> 4, qb = u & 15, b = bh >> 3, h = bh & 7, t = qb * 512 + tid; const size_t row = (size_t)b * SEQ + t;
        float q[64], o[64];
#pragma unroll
        for (int i = 0; i < 8; ++i) { const v4u w = *(const v4u*)(proj + row * NPJ + C_QS + h * 64 + 8 * i);
#pragma unroll
            for (int j = 0; j < 4; ++j) { q[8 * i + 2 * j] = __uint_as_float(w[j] << 16) * 0.125f; q[8 * i + 2 * j + 1] = __uint_as_float(w[j] & 0xffff0000u) * 0.125f; } }
#pragma unroll
        for (int d = 0; d < 64; ++d) o[d] = 0.f;
        float tail = 0.f;
        for (int kt = (qb * 512 + 511) / 32; kt >= 0; --kt) {
            if (__syncthreads_and(tail < -SB_EXIT_NAT)) break;
            { const int key = tid >> 4, d4 = (tid & 15) * 4; const size_t krow = (size_t)b * SEQ + kt * 32 + key;
              const v2u kk = *(const v2u*)(proj + krow * NPJ + C_KS + h * 64 + d4), vv = *(const v2u*)(proj + krow * NPJ + C_VS + h * 64 + d4);
              *(f32x4*)(Ks + key * 64 + d4) = (f32x4){__uint_as_float(kk.x << 16), __uint_as_float(kk.x & 0xffff0000u), __uint_as_float(kk.y << 16), __uint_as_float(kk.y & 0xffff0000u)};
              *(f32x4*)(Vs + key * 64 + d4) = (f32x4){__uint_as_float(vv.x << 16), __uint_as_float(vv.x & 0xffff0000u), __uint_as_float(vv.y << 16), __uint_as_float(vv.y & 0xffff0000u)}; }
            __syncthreads();
            for (int j = 31; j >= 0; --j) {
                const int s = kt * 32 + j;
                float z = 0.f;
#pragma unroll
                for (int d4 = 0; d4 < 16; ++d4) { const f32x4 k4 = *(const f32x4*)(Ks + j * 64 + 4 * d4); z += q[4 * d4] * k4.x + q[4 * d4 + 1] * k4.y + q[4 * d4 + 2] * k4.z + q[4 * d4 + 3] * k4.w; }
                const bool valid = s < t;
                const float lnb = logsig_neg(z);
                const float w = valid ? expf(z + lnb + tail) : 0.f;
                tail += valid ? lnb : 0.f;
#pragma unroll
                for (int d4 = 0; d4 < 16; ++d4) { const f32x4 v4 = *(const f32x4*)(Vs + j * 64 + 4 * d4); o[4 * d4] += w * v4.x; o[4 * d4 + 1] += w * v4.y; o[4 * d4 + 2] += w * v4.z; o[4 * d4 + 3] += w * v4.w; }
            }
        }
        float ss = 0.f;
#pragma unroll
        for (int d = 0; d < 64; ++d) ss += o[d] * o[d];
        const float r = rsqrtf(ss * (1.0f / 64.0f) + EPS);
#pragma unroll
        for (int i = 0; i < 8; ++i) { v4u w;
#pragma unroll
            for (int j = 0; j < 4; ++j) w[j] = pk2(o[8 * i + 2 * j] * r * F.sb_g[h * 64 + 8 * i + 2 * j], o[8 * i + 2 * j + 1] * r * F.sb_g[h * 64 + 8 * i + 2 * j + 1]);
            *(v4u*)(cat + row * DM + 512 + h * 64 + 8 * i) = w; }
    }
    __syncthreads();
}


typedef short bf16x8 __attribute__((ext_vector_type(8)));
typedef _Float16 f16x8 __attribute__((ext_vector_type(8)));
typedef float f32x16 __attribute__((ext_vector_type(16)));
constexpr float SB_EXIT_L2 = 44.0f;
__device__ __forceinline__ void ph_sb_mfma(Frame& F) {
    const bf16* proj = WSP(bf16, WS_PROJ); bf16* cat = WSP(bf16, WS_CAT);
    const int lane = F.lane, c = lane & 31, hf = lane >> 5;
    const int gw = F.vcu * NWAVES + F.wave, NGW = F.G * NWAVES;
    f16x8 tri[2];
#pragma unroll
    for (int ks = 0; ks < 2; ++ks)
#pragma unroll
        for (int i = 0; i < 8; ++i) { const int j = 16 * ks + 8 * (i >> 2) + 4 * hf + (i & 3); tri[ks][i] = (j >= c) ? (_Float16)1.0f : (_Float16)0.0f; }
    const float CS = 0.125f * 1.4426950408889634f;
    for (int u = gw; u < 4096; u += NGW) {
        const int bh = u >> 8, qb = u & 255, b = bh >> 3, h = bh & 7, q0 = qb * 32;
        const size_t row0 = (size_t)b * SEQ;
        bf16x8 qf[4];
#pragma unroll
        for (int s4 = 0; s4 < 4; ++s4) qf[s4] = *(const bf16x8*)(proj + (row0 + q0 + c) * NPJ + C_QS + h * 64 + 16 * s4 + 8 * hf);
        f32x16 o0, o1;
#pragma unroll
        for (int r = 0; r < 16; ++r) { o0[r] = 0.f; o1[r] = 0.f; }
        float carry = 0.f;
        for (int kt = qb; kt >= 0; --kt) {
            const int kbase = kt * 32;
            const bf16* kp = proj + (row0 + kbase + c) * NPJ + C_KS + h * 64 + 8 * hf;
            bf16x8 kf[4];
#pragma unroll
            for (int s4 = 0; s4 < 4; ++s4) kf[s4] = *(const bf16x8*)(kp + 16 * s4);
            bf16x8 vf[2][2];
#pragma unroll
            for (int db = 0; db < 2; ++db)
#pragma unroll
                for (int ks = 0; ks < 2; ++ks)
#pragma unroll
                    for (int i = 0; i < 8; ++i) { const int key = 16 * ks + 8 * (i >> 2) + 4 * hf + (i & 3);
                        vf[db][ks][i] = (short)proj[(row0 + kbase + key) * NPJ + C_VS + h * 64 + db * 32 + c]; }
            f32x16 z;
#pragma unroll
            for (int r = 0; r < 16; ++r) z[r] = 0.f;
#pragma unroll
            for (int s4 = 0; s4 < 4; ++s4) z = __builtin_amdgcn_mfma_f32_32x32x16_bf16(kf[s4], qf[s4], z, 0, 0, 0);
            const bool diag = (kt == qb);
            f32x16 cin; f16x8 lb[2];
#pragma unroll
            for (int r = 0; r < 16; ++r) {
                const int kl = (r & 3) + 8 * (r >> 2) + 4 * hf;
                const float z2 = z[r] * CS;
                const float l2 = fmaxf(z2, 0.f) + __builtin_amdgcn_logf(1.0f + __builtin_amdgcn_exp2f(-fabsf(z2)));
                const bool valid = !diag || (kl < c);
                lb[r >> 3][r & 7] = (_Float16)(valid ? -l2 : 0.f);
                cin[r] = z2 + carry;
            }
            f32x16 d = __builtin_amdgcn_mfma_f32_32x32x16_f16(tri[0], lb[0], cin, 0, 0, 0);
            d = __builtin_amdgcn_mfma_f32_32x32x16_f16(tri[1], lb[1], d, 0, 0, 0);
            v4u wb[2];
#pragma unroll
            for (int r = 0; r < 16; r += 2) {
                const int kl0 = (r & 3) + 8 * (r >> 2) + 4 * hf;
                const float w0 = (!diag || (kl0 < c)) ? __builtin_amdgcn_exp2f(d[r]) : 0.f;
                const float w1 = (!diag || (kl0 + 1 < c)) ? __builtin_amdgcn_exp2f(d[r + 1]) : 0.f;
                wb[r >> 3][(r & 7) >> 1] = pk2(w0, w1);
            }
            const bf16x8 wf0 = __builtin_bit_cast(bf16x8, wb[0]), wf1 = __builtin_bit_cast(bf16x8, wb[1]);
            o0 = __builtin_amdgcn_mfma_f32_32x32x16_bf16(vf[0][0], wf0, o0, 0, 0, 0);
            o0 = __builtin_amdgcn_mfma_f32_32x32x16_bf16(vf[0][1], wf1, o0, 0, 0, 0);
            o1 = __builtin_amdgcn_mfma_f32_32x32x16_bf16(vf[1][0], wf0, o1, 0, 0, 0);
            o1 = __builtin_amdgcn_mfma_f32_32x32x16_bf16(vf[1][1], wf1, o1, 0, 0, 0);
            float tot = d[0] - cin[0];
            tot = __shfl(tot, c);
            carry += tot;
            if (__all(carry < -SB_EXIT_L2)) break;
        }
        float ss = 0.f;
#pragma unroll
        for (int r = 0; r < 16; ++r) ss += o0[r] * o0[r] + o1[r] * o1[r];
        ss += __shfl_xor(ss, 32);
        const float rn = rsqrtf(ss * (1.0f / 64.0f) + EPS);
        bf16* op = cat + (row0 + q0 + c) * DM + 512 + h * 64 + 4 * hf;
#pragma unroll
        for (int g = 0; g < 4; ++g) {
            const f32x4 g0 = *(const f32x4*)(F.sb_g + h * 64 + 8 * g + 4 * hf), g1 = *(const f32x4*)(F.sb_g + h * 64 + 32 + 8 * g + 4 * hf);
            v2u a, bq;
            a.x = pk2(o0[4 * g] * rn * g0.x, o0[4 * g + 1] * rn * g0.y); a.y = pk2(o0[4 * g + 2] * rn * g0.z, o0[4 * g + 3] * rn * g0.w);
            bq.x = pk2(o1[4 * g] * rn * g1.x, o1[4 * g + 1] * rn * g1.y); bq.y = pk2(o1[4 * g + 2] * rn * g1.z, o1[4 * g + 3] * rn * g1.w);
            *(v2u*)(op + 8 * g) = a; *(v2u*)(op + 32 + 8 * g) = bq;
        }
    }
}
__device__ __forceinline__ void ph4_ln1(Frame& F) {
    const int gw = F.vcu * NWAVES + F.wave, NGW = F.G * NWAVES;
    float* x1 = WSP(float, WS_X1); bf16* x1b = WSP(bf16, WS_X1B);
    for (int m = gw; m < T; m += NGW) {
        f32x4 y[4]; float s = 0.f;
#pragma unroll
        for (int i = 0; i < 4; ++i) { const size_t o = (size_t)m * DM + 256 * i + 4 * F.lane; y[i] = *(const f32x4*)(F.x + o) * ALPHA + *(const f32x4*)(F.out + o); s += (y[i].x + y[i].y) + (y[i].z + y[i].w); }
        const float mean = wave_sum(s) * (1.0f / DM); float q = 0.f;
#pragma unroll
        for (int i = 0; i < 4; ++i) { y[i] = y[i] - mean; q += (y[i].x * y[i].x + y[i].y * y[i].y) + (y[i].z * y[i].z + y[i].w * y[i].w); }
        const float rstd = rsqrtf(wave_sum(q) * (1.0f / DM) + EPS);
#pragma unroll
        for (int i = 0; i < 4; ++i) { const int c = 256 * i + 4 * F.lane; const size_t o = (size_t)m * DM + c;
            const f32x4 r = y[i] * rstd * *(const f32x4*)(F.ln1_g + c) + *(const f32x4*)(F.ln1_b + c);
            *(f32x4*)(x1 + o) = r; v2u w; w.x = pk2(r.x, r.y); w.y = pk2(r.z, r.w); *(v2u*)(x1b + o) = w; }
    }
}

#define TOPK_INSERT(cv, ci, VAL, IDX) do { float _cv = (cv); int _ci = (ci); \
    _Pragma("unroll") for (int _j = 0; _j < 16; ++_j) { const bool _g = _cv > VAL[_j]; const float _tv = VAL[_j]; const int _ti = IDX[_j]; \
        VAL[_j] = _g ? _cv : _tv; IDX[_j] = _g ? _ci : _ti; _cv = _g ? _tv : _cv; _ci = _g ? _ti : _ci; } } while (0)
__device__ __forceinline__ void ph6_topk_naive(Frame& F) {
    const bf16* qry = WSP(bf16, WS_QRY); const bf16* skb = WSP(bf16, WS_SKB);
    int* pidx = WSP(int, WS_PIDX); float* pgate = WSP(float, WS_PGATE);
    float* sk = (float*)F.lds;
    const int tid = F.tid;
    for (int u = F.vcu; u < 256; u += F.G) {
        const int h = u >> 5, tb = u & 31, t = tb * 512 + tid;
        float sv[2][16]; int si[2][16];
#pragma unroll
        for (int p = 0; p < 2; ++p) {
            __syncthreads();
            for (int i = tid; i < 128 * 128 / 2; i += NTHR) { const unsigned w = *(const unsigned*)(skb + (size_t)(h * 2 + p) * 16384 + 2 * i); sk[2 * i] = __uint_as_float(w << 16); sk[2 * i + 1] = __uint_as_float(w & 0xffff0000u); }
            __syncthreads();
            unsigned qp[64];
#pragma unroll
            for (int i = 0; i < 16; ++i) { const v4u w = *(const v4u*)(qry + (size_t)t * 2048 + h * 256 + p * 128 + 8 * i); qp[4 * i] = w.x; qp[4 * i + 1] = w.y; qp[4 * i + 2] = w.z; qp[4 * i + 3] = w.w; }
#pragma unroll
            for (int j = 0; j < 16; ++j) { sv[p][j] = -INFINITY; si[p][j] = 0; }
            for (int n = 0; n < 128; ++n) {
                float s = 0.f;
#pragma unroll
                for (int c4 = 0; c4 < 32; ++c4) { const f32x4 k4 = *(const f32x4*)(sk + n * 128 + 4 * c4);
                    s += __uint_as_float(qp[2 * c4] << 16) * k4.x + __uint_as_float(qp[2 * c4] & 0xffff0000u) * k4.y + __uint_as_float(qp[2 * c4 + 1] << 16) * k4.z + __uint_as_float(qp[2 * c4 + 1] & 0xffff0000u) * k4.w; }
                TOPK_INSERT(s, n, sv[p], si[p]);
            }
        }
        float bv[16]; int bi[16];
#pragma unroll
        for (int j = 0; j < 16; ++j) { bv[j] = -INFINITY; bi[j] = 0; }
#pragma unroll
        for (int i = 0; i < 16; ++i)
#pragma unroll
            for (int j = 0; j < 16; ++j) TOPK_INSERT(sv[0][i] + sv[1][j], si[0][i] * 128 + si[1][j], bv, bi);
        float den = 0.f; float e[16];
#pragma unroll
        for (int j = 0; j < 16; ++j) { e[j] = expf(bv[j] - bv[0]); den += e[j]; }
        const float inv = 1.0f / den;
#pragma unroll
        for (int j4 = 0; j4 < 4; ++j4) {
            *(f32x4*)(pgate + (size_t)t * 128 + h * 16 + 4 * j4) = (f32x4){e[4 * j4] * inv, e[4 * j4 + 1] * inv, e[4 * j4 + 2] * inv, e[4 * j4 + 3] * inv};
            *(v4u*)(pidx + (size_t)t * 128 + h * 16 + 4 * j4) = (v4u){(unsigned)bi[4 * j4], (unsigned)bi[4 * j4 + 1], (unsigned)bi[4 * j4 + 2], (unsigned)bi[4 * j4 + 3]};
        }
    }
    __syncthreads();
}

__device__ __forceinline__ void ph7_peer_naive(Frame& F) {
    const int gw = F.vcu * NWAVES + F.wave, NGW = F.G * NWAVES;
    const float* x1 = WSP(float, WS_X1); const int* pidx = WSP(int, WS_PIDX); const float* pgate = WSP(float, WS_PGATE);
    for (int m = gw; m < T; m += NGW) {
        f32x4 xv[4], acc[4];
#pragma unroll
        for (int i = 0; i < 4; ++i) { xv[i] = *(const f32x4*)(x1 + (size_t)m * DM + 256 * i + 4 * F.lane); acc[i] = (f32x4){0.f, 0.f, 0.f, 0.f}; }
        for (int k = 0; k < 128; ++k) {
            const int e = __builtin_amdgcn_readfirstlane(pidx[(size_t)m * 128 + k]); const float g = pgate[(size_t)m * 128 + k];
            const float* ur = F.pu + (size_t)e * DM; const float* vr = F.pv + (size_t)e * DM;
            float p = 0.f;
#pragma unroll
            for (int i = 0; i < 4; ++i) { const f32x4 uu = *(const f32x4*)(ur + 256 * i + 4 * F.lane); p += (uu.x * xv[i].x + uu.y * xv[i].y) + (uu.z * xv[i].z + uu.w * xv[i].w); }
            p = wave_sum(p);
            const float w = g * 0.5f * p * (1.0f + erff(p * 0.70710678118654752f));
#pragma unroll
            for (int i = 0; i < 4; ++i) acc[i] += *(const f32x4*)(vr + 256 * i + 4 * F.lane) * w;
        }
        float s = 0.f;
#pragma unroll
        for (int i = 0; i < 4; ++i) { acc[i] = xv[i] * ALPHA + acc[i]; s += (acc[i].x + acc[i].y) + (acc[i].z + acc[i].w); }
        const float mean = wave_sum(s) * (1.0f / DM); float q = 0.f;
#pragma unroll
        for (int i = 0; i < 4; ++i) { acc[i] = acc[i] - mean; q += (acc[i].x * acc[i].x + acc[i].y * acc[i].y) + (acc[i].z * acc[i].z + acc[i].w * acc[i].w); }
        const float rstd = rsqrtf(wave_sum(q) * (1.0f / DM) + EPS);
#pragma unroll
        for (int i = 0; i < 4; ++i) { const int c = 256 * i + 4 * F.lane;
            *(f32x4*)(F.out + (size_t)m * DM + c) = acc[i] * rstd * *(const f32x4*)(F.ln2_g + c) + *(const f32x4*)(F.ln2_b + c); }
    }
}


__device__ __forceinline__ float gelu_erf(float p) { return 0.5f * p * (1.0f + erff(p * 0.70710678118654752f)); }
__device__ __forceinline__ void ph7_peer(Frame& F) {
    const int gw = F.vcu * NWAVES + F.wave, NGW = F.G * NWAVES, lane = F.lane;
    const float* x1 = WSP(float, WS_X1); const int* pidx = WSP(int, WS_PIDX); const float* pgate = WSP(float, WS_PGATE);
    const bf16* UB = WSP(bf16, WS_UB); const bf16* VB = WSP(bf16, WS_VB);
    const bool b5 = (lane & 32) != 0, b4 = (lane & 16) != 0, b3 = (lane & 8) != 0;
    for (int m = gw; m < T; m += NGW) {
        float xv[16], acc[16];
#pragma unroll
        for (int i = 0; i < 2; ++i) { const f32x4 a = *(const f32x4*)(x1 + (size_t)m * DM + 512 * i + 8 * lane), b = *(const f32x4*)(x1 + (size_t)m * DM + 512 * i + 8 * lane + 4);
            xv[8 * i] = a.x; xv[8 * i + 1] = a.y; xv[8 * i + 2] = a.z; xv[8 * i + 3] = a.w; xv[8 * i + 4] = b.x; xv[8 * i + 5] = b.y; xv[8 * i + 6] = b.z; xv[8 * i + 7] = b.w; }
#pragma unroll
        for (int i = 0; i < 16; ++i) acc[i] = 0.f;
        for (int k0 = 0; k0 < 128; k0 += 8) {
            const int ei = pidx[(size_t)m * 128 + k0 + (lane >> 3)]; const float gi = pgate[(size_t)m * 128 + k0 + (lane >> 3)];
            v4u uw[8][2], vw[8][2];
#pragma unroll
            for (int j = 0; j < 8; ++j) { const int e = __builtin_amdgcn_readlane(ei, 8 * j);
#pragma unroll
                for (int i = 0; i < 2; ++i) { uw[j][i] = *(const v4u*)(UB + (size_t)e * DM + 512 * i + 8 * lane); vw[j][i] = *(const v4u*)(VB + (size_t)e * DM + 512 * i + 8 * lane); } }
            float p[8];
#pragma unroll
            for (int j = 0; j < 8; ++j) { float a = 0.f;
#pragma unroll
                for (int i = 0; i < 2; ++i)
#pragma unroll
                    for (int q = 0; q < 4; ++q) { const unsigned w = uw[j][i][q]; a += __uint_as_float(w << 16) * xv[8 * i + 2 * q] + __uint_as_float(w & 0xffff0000u) * xv[8 * i + 2 * q + 1]; }
                p[j] = a; }
            float r1[4], r2[2];
#pragma unroll
            for (int j = 0; j < 4; ++j) r1[j] = (b5 ? p[j + 4] : p[j]) + __shfl_xor(b5 ? p[j] : p[j + 4], 32);
#pragma unroll
            for (int j = 0; j < 2; ++j) r2[j] = (b4 ? r1[j + 2] : r1[j]) + __shfl_xor(b4 ? r1[j] : r1[j + 2], 16);
            float r3 = (b3 ? r2[1] : r2[0]) + __shfl_xor(b3 ? r2[0] : r2[1], 8);
            r3 += __shfl_xor(r3, 4); r3 += __shfl_xor(r3, 2); r3 += __shfl_xor(r3, 1);
            const float wl = gi * gelu_erf(r3);
#pragma unroll
            for (int j = 0; j < 8; ++j) { const float w = __int_as_float(__builtin_amdgcn_readlane(__float_as_int(wl), 8 * j));
#pragma unroll
                for (int i = 0; i < 2; ++i)
#pragma unroll
                    for (int q = 0; q < 4; ++q) { const unsigned vwd = vw[j][i][q]; acc[8 * i + 2 * q] += w * __uint_as_float(vwd << 16); acc[8 * i + 2 * q + 1] += w * __uint_as_float(vwd & 0xffff0000u); } }
        }
        float s = 0.f;
#pragma unroll
        for (int i = 0; i < 16; ++i) { acc[i] = xv[i] * ALPHA + acc[i]; s += acc[i]; }
        const float mean = wave_sum(s) * (1.0f / DM); float q = 0.f;
#pragma unroll
        for (int i = 0; i < 16; ++i) { acc[i] -= mean; q += acc[i] * acc[i]; }
        const float rstd = rsqrtf(wave_sum(q) * (1.0f / DM) + EPS);
#pragma unroll
        for (int i = 0; i < 2; ++i)
#pragma unroll
            for (int hh = 0; hh < 2; ++hh) { const int c = 512 * i + 8 * lane + 4 * hh; const f32x4 g = *(const f32x4*)(F.ln2_g + c), bb = *(const f32x4*)(F.ln2_b + c);
                *(f32x4*)(F.out + (size_t)m * DM + c) = (f32x4){acc[8 * i + 4 * hh] * rstd * g.x + bb.x, acc[8 * i + 4 * hh + 1] * rstd * g.y + bb.y, acc[8 * i + 4 * hh + 2] * rstd * g.z + bb.z, acc[8 * i + 4 * hh + 3] * rstd * g.w + bb.w}; }
    }
}

__device__ __forceinline__ void ph9_peer_fp8(Frame& F) {
    const int gw = F.vcu * NWAVES + F.wave, NGW = F.G * NWAVES, lane = F.lane;
    const float* x1 = WSP(float, WS_X1); const int* pidx = WSP(int, WS_PIDX); const float* pgate = WSP(float, WS_PGATE);
    const unsigned char* U8 = F.ws + WS_U8; const unsigned char* V8 = F.ws + WS_V8; const float* rsu = WSP(float, WS_RSU); const float* rsv = WSP(float, WS_RSV);
    const bool b5 = (lane & 32) != 0, b4 = (lane & 16) != 0, b3 = (lane & 8) != 0, b2 = (lane & 4) != 0;
    for (int m = gw; m < T; m += NGW) {
        f32x2 xv[8], acc[8];
#pragma unroll
        for (int i = 0; i < 4; ++i) { const f32x4 a = *(const f32x4*)(x1 + (size_t)m * DM + 16 * lane + 4 * i); xv[2 * i] = (f32x2){a.x, a.y}; xv[2 * i + 1] = (f32x2){a.z, a.w}; }
#pragma unroll
        for (int i = 0; i < 8; ++i) acc[i] = (f32x2){0.f, 0.f};
        for (int k0 = 0; k0 < 128; k0 += 16) {
            const int ei = pidx[(size_t)m * 128 + k0 + (lane >> 2)]; const float gi = pgate[(size_t)m * 128 + k0 + (lane >> 2)];
            const float su = rsu[ei], sv = rsv[ei];
            v4u uw[16], vw[16];
#pragma unroll
            for (int j = 0; j < 16; ++j) { const int e = __builtin_amdgcn_readlane(ei, 4 * j);
                uw[j] = *(const v4u*)(U8 + (size_t)e * DM + 16 * lane); vw[j] = *(const v4u*)(V8 + (size_t)e * DM + 16 * lane); }
            float p[16];
#pragma unroll
            for (int j = 0; j < 16; ++j) { f32x2 a = (f32x2){0.f, 0.f};
#pragma unroll
                for (int q = 0; q < 4; ++q) { a += __builtin_amdgcn_cvt_pk_f32_fp8((int)uw[j][q], false) * xv[2 * q]; a += __builtin_amdgcn_cvt_pk_f32_fp8((int)uw[j][q], true) * xv[2 * q + 1]; }
                p[j] = a.x + a.y; }
            float r1[8], r2[4], r3[2];
#pragma unroll
            for (int j = 0; j < 8; ++j) r1[j] = (b5 ? p[j + 8] : p[j]) + __shfl_xor(b5 ? p[j] : p[j + 8], 32);
#pragma unroll
            for (int j = 0; j < 4; ++j) r2[j] = (b4 ? r1[j + 4] : r1[j]) + __shfl_xor(b4 ? r1[j] : r1[j + 4], 16);
#pragma unroll
            for (int j = 0; j < 2; ++j) r3[j] = (b3 ? r2[j + 2] : r2[j]) + __shfl_xor(b3 ? r2[j] : r2[j + 2], 8);
            float r4 = (b2 ? r3[1] : r3[0]) + __shfl_xor(b2 ? r3[0] : r3[1], 4);
            r4 += __shfl_xor(r4, 2); r4 += __shfl_xor(r4, 1);
            const float wl = gi * gelu_erf(r4 * su) * sv;
#pragma unroll
            for (int j = 0; j < 16; ++j) { const float w = __int_as_float(__builtin_amdgcn_readlane(__float_as_int(wl), 4 * j)); const f32x2 w2 = (f32x2){w, w};
#pragma unroll
                for (int q = 0; q < 4; ++q) { acc[2 * q] += __builtin_amdgcn_cvt_pk_f32_fp8((int)vw[j][q], false) * w2; acc[2 * q + 1] += __builtin_amdgcn_cvt_pk_f32_fp8((int)vw[j][q], true) * w2; } }
        }
        float s = 0.f;
#pragma unroll
        for (int i = 0; i < 8; ++i) { acc[i] = xv[i] * ALPHA + acc[i]; s += acc[i].x + acc[i].y; }
        const float mean = wave_sum(s) * (1.0f / DM); float q = 0.f;
#pragma unroll
        for (int i = 0; i < 8; ++i) { acc[i] = acc[i] - mean; q += acc[i].x * acc[i].x + acc[i].y * acc[i].y; }
        const float rstd = rsqrtf(wave_sum(q) * (1.0f / DM) + EPS);
#pragma unroll
        for (int i = 0; i < 4; ++i) { const int c = 16 * lane + 4 * i; const f32x4 g = *(const f32x4*)(F.ln2_g + c), bb = *(const f32x4*)(F.ln2_b + c);
            *(f32x4*)(F.out + (size_t)m * DM + c) = (f32x4){acc[2 * i].x * rstd * g.x + bb.x, acc[2 * i].y * rstd * g.y + bb.y, acc[2 * i + 1].x * rstd * g.z + bb.z, acc[2 * i + 1].y * rstd * g.w + bb.w}; }
    }
}
struct Args { const float* in[15]; float* out; unsigned char* ws; int ph_lo, ph_hi, li, pad; };
__global__ void __launch_bounds__(NTHR, 2) mk_fwd(Args args) {
    extern __shared__ __attribute__((aligned(16))) unsigned char lds[];
    Frame F;
    F.lds = lds; F.tid = threadIdx.x; F.lane = F.tid & 63; F.wave = __builtin_amdgcn_readfirstlane(F.tid >> 6);
    F.G = gridDim.x; { const int bx = blockIdx.x; F.vcu = (F.G % 8 == 0) ? (bx % 8) * (F.G / 8) + bx / 8 : bx; }
    F.x = args.in[0]; F.w_in = args.in[1]; F.w_gate = args.in[2]; F.b_gate = args.in[3]; F.gla_g = args.in[4]; F.sb_g = args.in[5]; F.w_out = args.in[6];
    F.ln1_g = args.in[7]; F.ln1_b = args.in[8]; F.w_q = args.in[9]; F.sub_keys = args.in[10]; F.pu = args.in[11]; F.pv = args.in[12]; F.ln2_g = args.in[13]; F.ln2_b = args.in[14];
    F.out = args.out; F.ws = args.ws;
    volatile LAS unsigned* MISC = (volatile LAS unsigned*)((LAS unsigned char*)lds + MISC_OFF);
    if (F.tid < 32) MISC[F.tid] = 0u;
    __syncthreads();
    unsigned* barw = (unsigned*)(F.ws + WS_CTL) + CW_BAR + args.li * XCD_BAR_WORDS;
    XcdBarrier bar; bar.bar = barw; bar.x = 0; bar.st = nullptr;
    const int lo = args.ph_lo, hi = args.ph_hi;
    if (hi - lo > 1) bar = xcd_barrier_post(barw, MISC + 8);
#ifndef PH_MASK
#define PH_MASK 0x3ff
#endif
#define IN(k) (((PH_MASK >> (k)) & 1) && lo <= (k) && (k) < hi)
#ifndef REP_PHASE
#define REP_PHASE -1
#endif
#ifndef REP_N
#define REP_N 2
#endif
#define SEAM(k) do { if (IN(k) && IN((k) + 1)) xcd_barrier(bar); } while (0)
#define REPS(k) (((k) == REP_PHASE) ? (1 + REP_N) : 1)
#ifndef NAIVE_MASK
#define NAIVE_MASK 0x00
#endif
#define NV(k) ((NAIVE_MASK >> (k)) & 1)
    LAS unsigned char* const ldsl = (LAS unsigned char*)lds;
    for (int rep_ = 0; rep_ < REPS(0); ++rep_) if (IN(0)) { if (rep_) xcd_barrier(bar); ph0_prologue(F); } SEAM(0);
    for (int rep_ = 0; rep_ < REPS(1); ++rep_) if (IN(1)) { if (rep_) xcd_barrier(bar);
        if (NV(1)) naive_gemm(F, WSP(bf16, WS_XB), WSP(bf16, WS_WTIN), T, NPJ, DM, EpiBf16Store{WSP(bf16, WS_PROJ), NPJ});
        else { pg8::Gemm g{WSP(bf16, WS_XB), WSP(bf16, WS_WTIN), T, NPJ, DM}; pg8::StaticOrder S; S.init(T, NPJ, F.G, (int)blockIdx.x);
            pg8::EpiBf16<0> E{WSP(bf16, WS_PROJ), NPJ, nullptr, 0, 0, 1.f};
            pg8::gemm_phase<pg8::EpiBf16<0>, pg8::StaticOrder, true, true>(ldsl, g, S, E); }
    } SEAM(1);
    for (int rep_ = 0; rep_ < REPS(2); ++rep_) if (IN(2)) { if (rep_) xcd_barrier(bar); gla_chunk_pass<false>(F); if (NV(2)) ph2_sb_naive(F); else ph_sb_mfma(F); } SEAM(2);
    for (int rep_ = 0; rep_ < REPS(3); ++rep_) if (IN(3)) { if (rep_) xcd_barrier(bar); gla_scan(F); } SEAM(3);
    for (int rep_ = 0; rep_ < REPS(4); ++rep_) if (IN(4)) { if (rep_) xcd_barrier(bar); gla_chunk_pass<true>(F); } SEAM(4);
    for (int rep_ = 0; rep_ < REPS(5); ++rep_) if (IN(5)) { if (rep_) xcd_barrier(bar);
        if (NV(5)) naive_gemm(F, WSP(bf16, WS_CAT), WSP(bf16, WS_WTOUT), T, DM, DM, EpiF32Store{F.out, DM});
        else { pg8::Gemm g{WSP(bf16, WS_CAT), WSP(bf16, WS_WTOUT), T, DM, DM}; pg8::StaticOrder S; S.init(T, DM, F.G, (int)blockIdx.x);
            pg8::EpiF32 E{F.out, DM};
            pg8::gemm_phase<pg8::EpiF32, pg8::StaticOrder, true, true>(ldsl, g, S, E); }
    } SEAM(5);
    for (int rep_ = 0; rep_ < REPS(6); ++rep_) if (IN(6)) { if (rep_) xcd_barrier(bar); ph4_ln1(F); } SEAM(6);
    for (int rep_ = 0; rep_ < REPS(7); ++rep_) if (IN(7)) { if (rep_) xcd_barrier(bar);
        if (NV(7)) naive_gemm(F, WSP(bf16, WS_X1B), WSP(bf16, WS_WTQ), T, 2048, DM, EpiBf16Store{WSP(bf16, WS_QRY), 2048});
        else { pg8::Gemm g{WSP(bf16, WS_X1B), WSP(bf16, WS_WTQ), T, 2048, DM}; pg8::StaticOrder S; S.init(T, 2048, F.G, (int)blockIdx.x);
            pg8::EpiBf16<0> E{WSP(bf16, WS_QRY), 2048, nullptr, 0, 0, 1.f};
            pg8::gemm_phase<pg8::EpiBf16<0>, pg8::StaticOrder, true, true>(ldsl, g, S, E); }
    } SEAM(7);
    for (int rep_ = 0; rep_ < REPS(8); ++rep_) if (IN(8)) { if (rep_) xcd_barrier(bar); ph6_topk_naive(F); } SEAM(8);
    for (int rep_ = 0; rep_ < REPS(9); ++rep_) if (IN(9)) { if (rep_) xcd_barrier(bar); if (NV(9)) ph7_peer_naive(F); else ph9_peer_fp8(F); }
#undef IN
#undef SEAM
}

extern "C" void kernel_launch(void* const* d_in, const int* in_sizes, int n_in, void* d_out, int out_size, void* d_ws, size_t ws_size, hipStream_t stream) {
    static int grid = 0;
    if (grid == 0) {
        if (n_in != 15 || in_sizes[0] != T * DM || out_size != T * DM || ws_size < WS_END) {
            fprintf(stderr, "kernel_launch: unexpected problem: n_in %d in0 %d out %d ws %zu (need %zu)\n", n_in, n_in > 0 ? in_sizes[0] : -1, out_size, ws_size, (size_t)WS_END); grid = -1; return; }
        int dev = 0, cus = 0;
        if (hipGetDevice(&dev) != hipSuccess || hipDeviceGetAttribute(&cus, hipDeviceAttributeMultiprocessorCount, dev) != hipSuccess) { grid = -1; return; }
        if (hipFuncSetAttribute((const void*)mk_fwd, hipFuncAttributeMaxDynamicSharedMemorySize, LDS_BYTES) != hipSuccess) { fprintf(stderr, "kernel_launch: hipFuncSetAttribute failed\n"); grid = -1; return; }
        (void)hipGetLastError();
        grid = cus;
    }
    if (grid < 0) return;
    if (hipMemsetAsync((char*)d_ws + WS_CTL, 0, CTL_ZERO_BYTES, stream) != hipSuccess) { fprintf(stderr, "kernel_launch: memset failed\n"); return; }
    Args a{};
    for (int i = 0; i < 15; ++i) a.in[i] = (const float*)d_in[i];
    a.out = (float*)d_out; a.ws = (unsigned char*)d_ws;
    constexpr int NL = MK_N_LAUNCHES;
    for (int li = 0; li < NL; ++li) {
        a.ph_lo = (NL == 1) ? 0 : li; a.ph_hi = (NL == 1) ? NPHASE : li + 1; a.li = li;
        hipLaunchKernelGGL(mk_fwd, dim3(grid), dim3(NTHR), LDS_BYTES, stream, a);
        const hipError_t le = hipPeekAtLastError();
        if (le != hipSuccess) { fprintf(stderr, "kernel_launch: launch %d failed: %s\n", li, hipGetErrorName(le)); break; }
    }
}
```

```cpp
#include <hip/hip_runtime.h>
#include <cstdio>
#include <cstdint>

#ifndef MK_N_LAUNCHES
#define MK_N_LAUNCHES 1
#endif

#define GAS __attribute__((address_space(1)))
#define LAS __attribute__((address_space(3)))
typedef unsigned short bf16;
typedef unsigned v4u __attribute__((ext_vector_type(4)));
typedef unsigned v2u __attribute__((ext_vector_type(2)));
typedef float f32x4 __attribute__((ext_vector_type(4)));
typedef float f32x2 __attribute__((ext_vector_type(2)));
typedef short bf16x8 __attribute__((ext_vector_type(8)));
typedef _Float16 f16x8 __attribute__((ext_vector_type(8)));
typedef float f32x16 __attribute__((ext_vector_type(16)));

constexpr int BATCH = 2, SEQ = 8192, DM = 1024, T = BATCH * SEQ;
constexpr int INW = 3088, NPJ = 3072;
constexpr int C_QG = 0, C_KG = 256, C_VG = 512, C_GG = 1024, C_QS = 1536, C_KS = 2048, C_VS = 2560;
constexpr int A_COL = 1536;
constexpr float ALPHA = 1.18920711500272f;
constexpr float EPS = 1e-5f;
constexpr int NWAVES = 8, NTHR = 512;
constexpr int NPHASE = 10;
constexpr float SB_EXIT_NAT = 30.0f;

constexpr size_t MiB = 1u << 20;
constexpr size_t WS_CTL = 0, CTL_ZERO_BYTES = 1 * MiB;
constexpr size_t WS_WTIN = 1 * MiB;
constexpr size_t WS_WTOUT = 7 * MiB;
constexpr size_t WS_WTQ = 9 * MiB;
constexpr size_t WS_SKB = 13 * MiB;
constexpr size_t WS_UB = 14 * MiB;
constexpr size_t WS_VB = 46 * MiB;
constexpr size_t WS_U8 = 14 * MiB;
constexpr size_t WS_V8 = 30 * MiB;
constexpr size_t WS_RSU = 46 * MiB;
constexpr size_t WS_RSV = 46 * MiB + 65536;
constexpr size_t WS_PROJ = 78 * MiB;
constexpr size_t WS_X1 = 78 * MiB, WS_X1B = 142 * MiB;
constexpr size_t WS_XB = 174 * MiB;
constexpr size_t WS_QRY = 174 * MiB;
constexpr size_t WS_CAT = 206 * MiB;
constexpr size_t WS_ST = 238 * MiB;
constexpr size_t WS_PIDX = 238 * MiB, WS_PGATE = 246 * MiB;
constexpr size_t WS_ALPHA = 238 * MiB;
constexpr size_t WS_SLOC = 174 * MiB;
constexpr size_t WS_DEC = 254 * MiB;
constexpr size_t WS_SBF = 48 * MiB;
constexpr size_t WS_END = 255 * MiB + 512 * 1024;

constexpr int CW_BAR = 4096;

constexpr int LDS_BYTES = 147456;
constexpr int MISC_OFF = 140 * 1024;

__device__ __forceinline__ float bf2f(unsigned v) { return __uint_as_float(v << 16); }
__device__ __forceinline__ unsigned f2bf(float f) { unsigned u = __float_as_uint(f); return (u + 0x7fffu + ((u >> 16) & 1u)) >> 16; }
__device__ __forceinline__ unsigned pk2(float lo, float hi) { return f2bf(lo) | (f2bf(hi) << 16); }
__device__ __forceinline__ float wave_sum(float v) {
#pragma unroll
    for (int o = 1; o < 64; o <<= 1) v += __shfl_xor(v, o);
    return v;
}
__device__ __forceinline__ float logsig_neg(float z) {
    return -(fmaxf(z, 0.f) + log1pf(expf(-fabsf(z))));
}

#define XB_TMO      128
#define XB_XCNT(j)  (256  + 64 * (j))
#define XB_XSUB(j)  (1280 + 64 * (j))
#define XB_XGEN(j)  (2304 + 64 * (j))
#define XB_TOP      3328
#define XB_TOPGEN   3392
#define XCD_BAR_WORDS 3456
#define XB_SPIN_CAP (1u << 23)
__device__ __forceinline__ unsigned xb_ld(unsigned* p)              { return __hip_atomic_load(p, __ATOMIC_RELAXED, __HIP_MEMORY_SCOPE_AGENT); }
__device__ __forceinline__ unsigned xb_add(unsigned* p, unsigned v) { return __hip_atomic_fetch_add(p, v, __ATOMIC_RELAXED, __HIP_MEMORY_SCOPE_AGENT); }
__device__ __forceinline__ unsigned xb_xcc_id() { return (unsigned)__builtin_amdgcn_s_getreg((3 << 11) | 20) & 0xFu; }
#define XB_SPIN(cond, bar) do { unsigned _sp = 0; while (cond) { __builtin_amdgcn_s_sleep(1); \
    if ((++_sp & 255u) == 0u) { if (xb_ld(&(bar)[XB_TMO])) break; if (_sp > XB_SPIN_CAP) { atomicAdd(&(bar)[XB_TMO], 1u); break; } } } } while (0)
struct XcdBarrier { unsigned* bar; unsigned x; volatile LAS unsigned* st; };
__device__ __forceinline__ XcdBarrier xcd_barrier_post(unsigned* bar, volatile LAS unsigned* st) {
    XcdBarrier b; b.bar = bar; b.x = xb_xcc_id(); b.st = st;
    if (threadIdx.x == 0) (void)xb_add(&bar[XB_XCNT(b.x)], 1u);
    return b;
}
__device__ __forceinline__ void xcd_barrier_complete(unsigned* bar, unsigned x, unsigned& nloc, unsigned& nx) {
    const unsigned G = gridDim.x * gridDim.y * gridDim.z;
    unsigned sum, cnt, mine, sp = 0u;
    for (;;) {
        sum = 0u; cnt = 0u; mine = 0u;
#pragma unroll
        for (unsigned j = 0; j < 16; ++j) { const unsigned c = xb_ld(&bar[XB_XCNT(j)]); sum += c; cnt += (c > 0u) ? 1u : 0u; mine = (j == x) ? c : mine; }
        if (sum == G) break;
        __builtin_amdgcn_s_sleep(1);
        if ((++sp & 255u) == 0u) { if (xb_ld(&bar[XB_TMO])) break; if (sp > XB_SPIN_CAP) { atomicAdd(&bar[XB_TMO], 1u); break; } }
    }
    nloc = mine > 0u ? mine : 1u; nx = cnt > 0u ? cnt : 1u;
}
__device__ __forceinline__ void xcd_barrier(const XcdBarrier& b) {
    asm volatile("s_waitcnt vmcnt(0)" ::: "memory");
    __syncthreads();
    if (threadIdx.x == 0) {
        unsigned* bar = b.bar;
        __builtin_amdgcn_s_waitcnt(0);
        unsigned nloc = b.st[0], nx = b.st[1];
        if (nloc == 0u) { xcd_barrier_complete(bar, b.x, nloc, nx); b.st[0] = nloc; b.st[1] = nx; }
        const unsigned old = xb_add(&bar[XB_XSUB(b.x)], 1u);
        const unsigned gen = old / nloc;
        if (old + 1u == (gen + 1u) * nloc) {
            __builtin_amdgcn_fence(__ATOMIC_RELEASE, "agent");
            asm volatile("s_waitcnt vmcnt(0)" ::: "memory");
            const unsigned og = xb_add(&bar[XB_TOP], 1u);
            const unsigned tg = og / nx;
            if (og + 1u == (tg + 1u) * nx) xb_add(&bar[XB_TOPGEN], 1u);
            else XB_SPIN(xb_ld(&bar[XB_TOPGEN]) == tg, bar);
            __builtin_amdgcn_fence(__ATOMIC_ACQUIRE, "agent");
            xb_add(&bar[XB_XGEN(b.x)], 1u);
            asm volatile("s_waitcnt vmcnt(0)" ::: "memory");
        } else {
            XB_SPIN(xb_ld(&bar[XB_XGEN(b.x)]) == gen, bar);
            __builtin_amdgcn_fence(__ATOMIC_ACQUIRE, "agent");
            asm volatile("s_waitcnt vmcnt(0)" ::: "memory");
        }
    }
    __syncthreads();
}

namespace pg8 {
#define PG8_LAS __attribute__((address_space(3)))
typedef unsigned short bf16_t;
typedef short bf16x8 __attribute__((ext_vector_type(8)));
typedef float f32x4 __attribute__((ext_vector_type(4)));
typedef unsigned u32x4 __attribute__((ext_vector_type(4)));
constexpr int BM = 256, BK = 64, HALF = 128, HTB = HALF * BK * 2  , STAGE_BYTES = 8 * HTB, NXCD = 8, WGM = 8;

__host__ __device__ __forceinline__ int lds_byte(int r, int c) { const int st = (r >> 4) * 2 + (c >> 5), rr = r & 15, cc = c & 31, ob = rr * 64 + cc * 2; return st * 1024 + (ob ^ (((ob >> 9) & 1) << 5)); }
__host__ __device__ __forceinline__ void stage_rc(int b, int& R, int& C) { const int st = b / 1024, sb = b % 1024, swz = sb ^ (((sb >> 9) & 1) << 5); R = (st >> 1) * 16 + swz / 64; C = (st & 1) * 32 + (swz % 64) / 2; }
__host__ __device__ __forceinline__ int perm32(int rho) { const int n = rho >> 4, i = rho & 15; return 8 * (i >> 2) + 4 * n + (i & 3); }

struct Unit { int pm, pn; };
struct Gemm { const bf16_t* A; const bf16_t* Bt; int M, N, K; };

struct StaticOrder {
    int nM, nN, nwg, G, c;
    __host__ __device__ void init(int M, int N, int G_, int c_) { nM = M / BM; nN = N / BM; nwg = nM * nN; G = G_; c = c_; }
    __host__ __device__ bool next(int i, Unit& u) const {
        const long L = (long)i * G + c; if (L >= nwg) return false;
        int wgid = (int)L; { const int q = nwg / NXCD, r = nwg % NXCD, xcd = wgid % NXCD, off = wgid / NXCD; wgid = (xcd < r ? xcd * (q + 1) : r * (q + 1) + (xcd - r) * q) + off; }
        const int nig = WGM * nN, gid = wgid / nig, fm = gid * WGM, gsz = (nM - fm) < WGM ? (nM - fm) : WGM;
        u.pm = fm + ((wgid % nig) % gsz); u.pn = (wgid % nig) / gsz; return true;
    }
    __device__ __forceinline__ void a_ready(const Unit&) const {}
    __device__ __forceinline__ void done(const Unit&) const {}
};

__device__ __forceinline__ unsigned cvt_pk_bf16(float lo, float hi) { unsigned r; asm volatile("v_cvt_pk_bf16_f32 %0, %1, %2" : "=v"(r) : "v"(lo), "v"(hi)); return r; }
typedef float f32x2 __attribute__((ext_vector_type(2)));
__device__ __forceinline__ f32x2 gelu_pk(f32x2 v) {
    const f32x2 av = __builtin_elementwise_abs(v), d = av * 0.2316418882f + 1.0f;
    f32x2 t; t.x = __builtin_amdgcn_rcpf(d.x); t.y = __builtin_amdgcn_rcpf(d.y);
    f32x2 q = t * 0.5307027145f + (-0.7265760135f); q = q * t + 0.7107068705f; q = q * t + (-0.142248368f); q = q * t + 0.127414796f; q = q * t;
    const f32x2 s = (v * v) * (-0.72134752044f);
    f32x2 e; e.x = __builtin_amdgcn_exp2f(s.x); e.y = __builtin_amdgcn_exp2f(s.y);
    const f32x2 m = v * (q * e), r = v - m;
    f32x2 o; o.x = v.x < 0.f ? m.x : r.x; o.y = v.y < 0.f ? m.y : r.y; return o;
}

template <int ACT  > struct EpiBf16 {
    static constexpr bool PERM = true, AFTER_DRAIN = false; static_assert(ACT == 0 || ACT == 1, "EpiBf16: ACT is 0 (none) or 1 (gelu_pk)");
    bf16_t* O; int ldc; const float* bias; int split_cols; size_t split_stride; float scale0;
    __device__ __forceinline__ void operator()(const f32x4 (&acc)[2][2][4][2], const Unit& u, int wr, int wc, int fr, int fq) const {
        const int row0 = u.pm * BM + wr * 64 + fr; int colt = u.pn * BM; bf16_t* base = O;
        float sc = 1.f; if (split_cols) { const int t = colt / split_cols; base += (size_t)t * split_stride; colt -= t * split_cols; if (t == 0) sc = scale0; }
        const int col0 = colt + wc * 32 + 8 * fq, bcol0 = u.pn * BM + wc * 32 + 8 * fq;
        f32x4 bv[2][2];
#pragma unroll
        for (int bj = 0; bj < 2; ++bj)
#pragma unroll
            for (int n = 0; n < 2; ++n) bv[bj][n] = bias ? *(const f32x4*)(bias + bcol0 + bj * HALF + 4 * n) : (f32x4){0.f, 0.f, 0.f, 0.f};
#pragma unroll
        for (int ai = 0; ai < 2; ++ai)
#pragma unroll
            for (int m = 0; m < 4; ++m) { bf16_t* rowp = base + (size_t)(row0 + ai * HALF + m * 16) * ldc + col0;
#pragma unroll
                for (int bj = 0; bj < 2; ++bj) { f32x4 v0 = acc[ai][bj][m][0] + bv[bj][0], v1 = acc[ai][bj][m][1] + bv[bj][1];
                    if (ACT == 1) { f32x2 a = gelu_pk((f32x2){v0[0], v0[1]}), b = gelu_pk((f32x2){v0[2], v0[3]}), c = gelu_pk((f32x2){v1[0], v1[1]}), d = gelu_pk((f32x2){v1[2], v1[3]});
                        v0 = (f32x4){a.x, a.y, b.x, b.y}; v1 = (f32x4){c.x, c.y, d.x, d.y}; }
                    v0 = v0 * sc; v1 = v1 * sc; u32x4 w; w.x = cvt_pk_bf16(v0[0], v0[1]); w.y = cvt_pk_bf16(v0[2], v0[3]); w.z = cvt_pk_bf16(v1[0], v1[1]); w.w = cvt_pk_bf16(v1[2], v1[3]);
                    *(u32x4*)(rowp + bj * HALF) = w; } }
    }
};

struct EpiF32 {
    static constexpr bool PERM = true, AFTER_DRAIN = false;
    float* O; int ldc;
    __device__ __forceinline__ void operator()(const f32x4 (&acc)[2][2][4][2], const Unit& u, int wr, int wc, int fr, int fq) const {
        const int row0 = u.pm * BM + wr * 64 + fr, col0 = u.pn * BM + wc * 32 + 8 * fq;
#pragma unroll
        for (int ai = 0; ai < 2; ++ai)
#pragma unroll
            for (int m = 0; m < 4; ++m) { float* rowp = O + (size_t)(row0 + ai * HALF + m * 16) * ldc + col0;
#pragma unroll
                for (int bj = 0; bj < 2; ++bj) { *(f32x4*)(rowp + bj * HALF) = acc[ai][bj][m][0]; *(f32x4*)(rowp + bj * HALF + 4) = acc[ai][bj][m][1]; } }
    }
};
template <class Epi, class Sched, bool ALIGN_EPI = false, bool SP2 = false>
__device__ __forceinline__ void gemm_phase(PG8_LAS unsigned char* lds, const Gemm g, const Sched& S, const Epi& E) {
    const int tid = threadIdx.x, wid = __builtin_amdgcn_readfirstlane(tid >> 6), lane = tid & 63, wr = wid >> 2, wc = wid & 3, fr = lane & 15, fq = lane >> 4;
    const int K = g.K, nt = K / BK;
    unsigned voffA[2], voffB[2];
#pragma unroll
    for (int i = 0; i < 2; ++i) { int R, C; stage_rc(tid * 16 + i * 8192, R, C); const int Rb = Epi::PERM ? ((R & ~31) + perm32(R & 31)) : R;
        voffA[i] = (unsigned)(R * K + C) * 2u; voffB[i] = (unsigned)(Rb * K + C) * 2u; }
    const size_t kstep = (size_t)(BK * 2);
    const size_t hstep = (size_t)HALF * K * 2;
    const size_t tstep = 2 * hstep;
    const unsigned ldsw = (unsigned)wid * 1024u;
    const int aoff = lds_byte(wr * 64 + fr, fq * 8), boff = lds_byte(wc * 32 + fr, fq * 8);
#define PG8_SA(b, h) (((b) * 2 + (h)) * HTB)
#define PG8_SB(b, h) ((4 + (b) * 2 + (h)) * HTB)
#define PG8_STAGE(bufoff, gbase, voff) do { _Pragma("unroll") for (int _i = 0; _i < 2; ++_i) \
        __builtin_amdgcn_global_load_lds((const unsigned*)((const char*)(gbase) + (voff)[_i]), (PG8_LAS unsigned*)(lds + (bufoff) + ldsw + _i * 8192), 16, 0, 0); } while (0)
#define PG8_LDA(dst, b, h) do { _Pragma("unroll") for (int m = 0; m < 4; ++m) _Pragma("unroll") for (int k = 0; k < 2; ++k) dst[m][k] = *(const PG8_LAS bf16x8*)(lds + PG8_SA(b, h) + aoff + m * 2048 + k * 1024); } while (0)
#define PG8_LDB(dst, b, h) do { _Pragma("unroll") for (int n = 0; n < 2; ++n) _Pragma("unroll") for (int k = 0; k < 2; ++k) dst[n][k] = *(const PG8_LAS bf16x8*)(lds + PG8_SB(b, h) + boff + n * 2048 + k * 1024); } while (0)
#define PG8_MMA(ai, bj, At, Bt) do { __builtin_amdgcn_s_setprio(1); _Pragma("unroll") for (int m = 0; m < 4; ++m) _Pragma("unroll") for (int n = 0; n < 2; ++n) _Pragma("unroll") for (int k = 0; k < 2; ++k) \
        acc[ai][bj][m][n] = __builtin_amdgcn_mfma_f32_16x16x32_bf16(Bt[n][k], At[m][k], acc[ai][bj][m][n], 0, 0, 0); __builtin_amdgcn_s_setprio(0); } while (0)
#define PG8_WAIT_V(n) asm volatile("s_waitcnt vmcnt(" #n ")" ::: "memory")
#define PG8_WAIT_L(n) asm volatile("s_waitcnt lgkmcnt(" #n ")" ::: "memory")
#define PG8_BAR __builtin_amdgcn_s_barrier()
#define PG8_SCHED __builtin_amdgcn_sched_barrier(0)
    Unit cur, nxt; int ui = 0;
    if (!S.next(0, cur)) return;
    f32x4 acc[2][2][4][2];
#pragma unroll
    for (int a = 0; a < 2; ++a)
#pragma unroll
        for (int b = 0; b < 2; ++b)
#pragma unroll
            for (int m = 0; m < 4; ++m)
#pragma unroll
                for (int n = 0; n < 2; ++n) acc[a][b][m][n] = (f32x4){0.f, 0.f, 0.f, 0.f};
    bf16x8 At[4][2], B0[2][2], B1[2][2];
    const char* cA = (const char*)g.A + (size_t)cur.pm * tstep; const char* cB = (const char*)g.Bt + (size_t)cur.pn * tstep;
    S.a_ready(cur);
    if constexpr (SP2) {
        PG8_STAGE(PG8_SB(0, 0), cB, voffB); PG8_STAGE(PG8_SB(0, 1), cB + hstep, voffB); PG8_STAGE(PG8_SA(0, 0), cA, voffA); PG8_STAGE(PG8_SA(0, 1), cA + hstep, voffA);
        if (wr == 1) PG8_BAR;
        PG8_WAIT_V(2); PG8_BAR;
        PG8_STAGE(PG8_SB(1, 0), cB + kstep, voffB); PG8_STAGE(PG8_SA(1, 0), cA + kstep, voffA); PG8_STAGE(PG8_SB(1, 1), cB + hstep + kstep, voffB);
        PG8_WAIT_V(6); PG8_BAR;
    } else {
        PG8_STAGE(PG8_SB(0, 0), cB, voffB); PG8_STAGE(PG8_SA(0, 0), cA, voffA); PG8_STAGE(PG8_SB(0, 1), cB + hstep, voffB); PG8_STAGE(PG8_SA(0, 1), cA + hstep, voffA);
        if (wr == 1) PG8_BAR;
        PG8_WAIT_V(4); PG8_BAR;
        PG8_STAGE(PG8_SB(1, 0), cB + kstep, voffB); PG8_STAGE(PG8_SA(1, 0), cA + kstep, voffA); PG8_STAGE(PG8_SB(1, 1), cB + hstep + kstep, voffB);
        PG8_WAIT_V(6); PG8_BAR;
    }
    for (;;) {
        const bool has_next = S.next(ui + 1, nxt);
        const char* nA = has_next ? (const char*)g.A + (size_t)nxt.pm * tstep : cA; const char* nB = has_next ? (const char*)g.Bt + (size_t)nxt.pn * tstep : cB;
        for (int t = 0; t < nt; t += 2) {
            const bool last = (t == nt - 2);
            const char* a1 = cA + (size_t)(t + 1) * kstep;
            const char* a2 = last ? nA : cA + (size_t)(t + 2) * kstep; const char* b2 = last ? nB : cB + (size_t)(t + 2) * kstep;
            const char* a3 = a2 + kstep; const char* b3 = b2 + kstep;
            if (last && has_next) S.a_ready(nxt);
            if constexpr (SP2) {
            PG8_LDB(B0, 0, 0); PG8_LDB(B1, 0, 1); PG8_SCHED; PG8_LDA(At, 0, 0); PG8_STAGE(PG8_SA(1, 1), a1 + hstep, voffA);
            PG8_WAIT_V(8); PG8_WAIT_L(0); PG8_BAR; PG8_MMA(0, 0, At, B0); PG8_MMA(0, 1, At, B1); PG8_BAR; PG8_SCHED;
            PG8_LDA(At, 0, 1); PG8_STAGE(PG8_SB(0, 0), b2, voffB); PG8_STAGE(PG8_SB(0, 1), b2 + hstep, voffB); PG8_STAGE(PG8_SA(0, 0), a2, voffA);
            PG8_WAIT_V(8); PG8_WAIT_L(0); PG8_BAR; PG8_MMA(1, 0, At, B0); PG8_MMA(1, 1, At, B1); PG8_BAR; PG8_SCHED;
            PG8_LDB(B0, 1, 0); PG8_LDB(B1, 1, 1); PG8_SCHED; PG8_LDA(At, 1, 0); PG8_STAGE(PG8_SA(0, 1), a2 + hstep, voffA);
            PG8_WAIT_V(8); PG8_WAIT_L(0); PG8_BAR; PG8_MMA(0, 0, At, B0); PG8_MMA(0, 1, At, B1); PG8_BAR; PG8_SCHED;
            PG8_LDA(At, 1, 1); PG8_STAGE(PG8_SB(1, 0), b3, voffB); PG8_STAGE(PG8_SB(1, 1), b3 + hstep, voffB); PG8_STAGE(PG8_SA(1, 0), a3, voffA);
            PG8_WAIT_V(8); PG8_WAIT_L(0); PG8_BAR; PG8_MMA(1, 0, At, B0); PG8_MMA(1, 1, At, B1); PG8_BAR; PG8_SCHED;
            } else {
            PG8_LDB(B0, 0, 0); PG8_SCHED; PG8_LDA(At, 0, 0); PG8_STAGE(PG8_SA(1, 1), a1 + hstep, voffA);
            PG8_WAIT_L(8); PG8_BAR; PG8_WAIT_L(0); PG8_MMA(0, 0, At, B0); PG8_BAR; PG8_SCHED;
            PG8_LDB(B1, 0, 1); PG8_STAGE(PG8_SB(0, 0), b2, voffB);
            PG8_BAR; PG8_WAIT_L(0); PG8_MMA(0, 1, At, B1); PG8_BAR;
            PG8_LDA(At, 0, 1); PG8_STAGE(PG8_SA(0, 0), a2, voffA);
            PG8_BAR; PG8_WAIT_L(0); PG8_MMA(1, 0, At, B0); PG8_BAR; PG8_SCHED;
            PG8_STAGE(PG8_SB(0, 1), b2 + hstep, voffB);
            PG8_WAIT_V(6); PG8_BAR; PG8_MMA(1, 1, At, B1); PG8_BAR;
            PG8_LDB(B0, 1, 0); PG8_SCHED; PG8_LDA(At, 1, 0); PG8_STAGE(PG8_SA(0, 1), a2 + hstep, voffA);
            PG8_WAIT_L(8); PG8_BAR; PG8_WAIT_L(0); PG8_MMA(0, 0, At, B0); PG8_BAR; PG8_SCHED;
            PG8_LDB(B1, 1, 1); PG8_STAGE(PG8_SB(1, 0), b3, voffB);
            PG8_BAR; PG8_WAIT_L(0); PG8_MMA(0, 1, At, B1); PG8_BAR;
            PG8_LDA(At, 1, 1); PG8_STAGE(PG8_SA(1, 0), a3, voffA);
            PG8_BAR; PG8_WAIT_L(0); PG8_MMA(1, 0, At, B0); PG8_BAR; PG8_SCHED;
            PG8_STAGE(PG8_SB(1, 1), b3 + hstep, voffB);
            PG8_WAIT_V(6); PG8_BAR; PG8_MMA(1, 1, At, B1); PG8_BAR;
            }
        }
        if constexpr (ALIGN_EPI) { if (wr == 0) PG8_BAR; }
        if constexpr (!Epi::AFTER_DRAIN) { E(acc, cur, wr, wc, fr, fq); S.done(cur); }
        if (!has_next) break;
#pragma unroll
        for (int a = 0; a < 2; ++a)
#pragma unroll
            for (int b = 0; b < 2; ++b)
#pragma unroll
                for (int m = 0; m < 4; ++m)
#pragma unroll
                    for (int n = 0; n < 2; ++n) acc[a][b][m][n] = (f32x4){0.f, 0.f, 0.f, 0.f};
        cur = nxt; cA = nA; cB = nB; ++ui;
        if constexpr (ALIGN_EPI) { if (wr == 1) PG8_BAR; }
    }
    PG8_WAIT_V(0);
    if constexpr (!ALIGN_EPI) { if (wr == 0) PG8_BAR; }
    PG8_BAR;
    if constexpr (Epi::AFTER_DRAIN) { E.fused(acc, cur, wr, wc, fr, fq, lds, wid, lane); S.done(cur); }
#undef PG8_SA
#undef PG8_SB
#undef PG8_STAGE
#undef PG8_LDA
#undef PG8_LDB
#undef PG8_MMA
#undef PG8_WAIT_V
#undef PG8_WAIT_L
#undef PG8_BAR
#undef PG8_SCHED
}
}

struct Frame {
    unsigned char* lds;
    int tid, lane, wave, vcu, G;
    const float *x, *w_in, *w_gate, *b_gate, *gla_g, *sb_g, *w_out, *ln1_g, *ln1_b, *w_q, *sub_keys, *pu, *pv, *ln2_g, *ln2_b;
    float* out;
    unsigned char* ws;
};
#define WSP(type, off) ((type*)(F.ws + (off)))

__device__ __forceinline__ void p0_transpose_item(const float* W, int K, int ldw, int c0, int ncols, bf16* WT, int row_off, float* scr, int item, int lane) {
    const int nblk = ncols / 32, kb = item / nblk, nb = item % nblk, k0 = 64 * kb, n0 = 32 * nb;
#pragma unroll 8
    for (int i = 0; i < 32; ++i) { const int kk = 2 * i + (lane >> 5); scr[kk * 33 + (lane & 31)] = W[(size_t)(k0 + kk) * ldw + c0 + n0 + (lane & 31)]; }
    asm volatile("s_waitcnt lgkmcnt(0)" ::: "memory");
    const int c = lane & 7;
#pragma unroll
    for (int j = 0; j < 4; ++j) { const int n = (lane >> 3) + 8 * j; const float* s = scr + (8 * c) * 33 + n;
        v4u o; o.x = pk2(s[0 * 33], s[1 * 33]); o.y = pk2(s[2 * 33], s[3 * 33]); o.z = pk2(s[4 * 33], s[5 * 33]); o.w = pk2(s[6 * 33], s[7 * 33]);
        *(v4u*)(WT + (size_t)(row_off + n0 + n) * K + k0 + 8 * c) = o; }
    asm volatile("s_waitcnt lgkmcnt(0)" ::: "memory");
}
__device__ __forceinline__ void cvt_f32_bf16_bulk(Frame& F, const float* src, bf16* dst, size_t n8) {
    const size_t gt = (size_t)F.vcu * NTHR + F.tid, NT = (size_t)F.G * NTHR;
    for (size_t i = gt; i < n8; i += NT) {
        const f32x4 a = *(const f32x4*)(src + i * 8), b = *(const f32x4*)(src + i * 8 + 4);
        v4u o; o.x = pk2(a.x, a.y); o.y = pk2(a.z, a.w); o.z = pk2(b.x, b.y); o.w = pk2(b.z, b.w);
        *(v4u*)(dst + i * 8) = o;
    }
}
__device__ __forceinline__ void ph0_prologue(Frame& F) {
    float* wa = (float*)F.lds;
    float* scr = (float*)(F.lds + 65536 + F.wave * 8448);
    const int gw = F.vcu * NWAVES + F.wave, NGW = F.G * NWAVES;
    for (int idx = F.tid; idx < 16384; idx += NTHR) { const int k = idx >> 4, r = idx & 15; wa[r * 1024 + k] = F.w_in[(size_t)k * INW + A_COL + r]; }
    constexpr int I_IN1 = 16 * 48, I_IN2 = 16 * 48, I_OUT = 16 * 32, I_Q = 16 * 64, NITEMS = I_IN1 + I_IN2 + I_OUT + I_Q;
    for (int it = gw; it < NITEMS; it += NGW) {
        int r = it;
        if (r < I_IN1) { p0_transpose_item(F.w_in, 1024, INW, 0, 1536, WSP(bf16, WS_WTIN), 0, scr, r, F.lane); continue; } r -= I_IN1;
        if (r < I_IN2) { p0_transpose_item(F.w_in, 1024, INW, 1552, 1536, WSP(bf16, WS_WTIN), 1536, scr, r, F.lane); continue; } r -= I_IN2;
        if (r < I_OUT) { p0_transpose_item(F.w_out, 1024, 1024, 0, 1024, WSP(bf16, WS_WTOUT), 0, scr, r, F.lane); continue; } r -= I_OUT;
        p0_transpose_item(F.w_q, 1024, 2048, 0, 2048, WSP(bf16, WS_WTQ), 0, scr, r, F.lane);
    }
    cvt_f32_bf16_bulk(F, F.sub_keys, WSP(bf16, WS_SKB), (size_t)8 * 2 * 128 * 128 / 8);
    for (int it = gw; it < 2 * 16384; it += NGW) {
        const int tb = it >> 14, e = it & 16383; const float* src = (tb ? F.pv : F.pu) + (size_t)e * DM + 16 * F.lane;
        f32x4 a[4]; float mx = 0.f;
#pragma unroll
        for (int j = 0; j < 4; ++j) { a[j] = *(const f32x4*)(src + 4 * j); mx = fmaxf(mx, fmaxf(fmaxf(fabsf(a[j].x), fabsf(a[j].y)), fmaxf(fabsf(a[j].z), fabsf(a[j].w)))); }
#pragma unroll
        for (int o = 1; o < 64; o <<= 1) mx = fmaxf(mx, __shfl_xor(mx, o));
        const float sc = (mx > 0.f) ? 384.0f / mx : 1.0f;
        v4u q;
#pragma unroll
        for (int j = 0; j < 4; ++j) { int w = __builtin_amdgcn_cvt_pk_fp8_f32(a[j].x * sc, a[j].y * sc, 0, false); w = __builtin_amdgcn_cvt_pk_fp8_f32(a[j].z * sc, a[j].w * sc, w, true); q[j] = (unsigned)w; }
        *(v4u*)(F.ws + (tb ? WS_V8 : WS_U8) + (size_t)e * DM + 16 * F.lane) = q;
        if (F.lane == 0) WSP(float, tb ? WS_RSV : WS_RSU)[e] = 1.0f / sc;
    }
    __syncthreads();
    bf16* xb = WSP(bf16, WS_XB); float* alpha = WSP(float, WS_ALPHA);
    float wgr[16][4], bgr[4];
#pragma unroll
    for (int i = 0; i < 4; ++i) { bgr[i] = F.b_gate[F.lane + 64 * i];
#pragma unroll
        for (int r = 0; r < 16; ++r) wgr[r][i] = F.w_gate[r * 256 + F.lane + 64 * i]; }
    for (int m = gw; m < T; m += NGW) {
        const float* xr = F.x + (size_t)m * DM;
        f32x4 xv[4];
#pragma unroll
        for (int i = 0; i < 4; ++i) { xv[i] = *(const f32x4*)(xr + 256 * i + 4 * F.lane);
            v2u o; o.x = pk2(xv[i].x, xv[i].y); o.y = pk2(xv[i].z, xv[i].w); *(v2u*)(xb + (size_t)m * DM + 256 * i + 4 * F.lane) = o; }
        float sg[4] = {bgr[0], bgr[1], bgr[2], bgr[3]};
#pragma unroll
        for (int r = 0; r < 16; ++r) {
            float a = 0.f;
#pragma unroll
            for (int i = 0; i < 4; ++i) { const f32x4 w = *(const f32x4*)(wa + r * 1024 + 256 * i + 4 * F.lane); a += xv[i].x * w.x + xv[i].y * w.y + xv[i].z * w.z + xv[i].w * w.w; }
            a = wave_sum(a);
#pragma unroll
            for (int i = 0; i < 4; ++i) sg[i] += a * wgr[r][i];
            asm volatile("" ::: "memory");
        }
#pragma unroll
        for (int i = 0; i < 4; ++i) { const float la = -(fmaxf(-sg[i], 0.f) + log1pf(expf(-fabsf(sg[i])))) * (1.0f / 16.0f);
            alpha[(size_t)m * 256 + F.lane + 64 * i] = la * 1.4426950408889634f; }
    }
}

struct EpiBf16Store { bf16* C; int ldc;
    __device__ __forceinline__ void operator()(int row, int col, const float (&acc)[8][4]) const {
#pragma unroll
        for (int i = 0; i < 8; ++i) { v2u o; o.x = pk2(acc[i][0], acc[i][1]); o.y = pk2(acc[i][2], acc[i][3]); *(v2u*)(C + (size_t)(row + i) * ldc + col) = o; } } };
struct EpiF32Store { float* C; int ldc;
    __device__ __forceinline__ void operator()(int row, int col, const float (&acc)[8][4]) const {
#pragma unroll
        for (int i = 0; i < 8; ++i) *(f32x4*)(C + (size_t)(row + i) * ldc + col) = (f32x4){acc[i][0], acc[i][1], acc[i][2], acc[i][3]}; } };
template <class Epi>
__device__ __forceinline__ void naive_gemm(Frame& F, const bf16* A, const bf16* Bt, int M, int N, int K, const Epi& epi) {
    float* As = (float*)F.lds; float* Bs = As + 32 * 132;
    const int tid = F.tid, tm = tid >> 5, tn = tid & 31, lr = tid >> 2, lk = (tid & 3) * 8;
    const int nN = N / 128, nU = (M / 128) * nN;
    for (int u = F.vcu; u < nU; u += F.G) {
        const int pm = u / nN, pn = u % nN;
        float acc[8][4];
#pragma unroll
        for (int i = 0; i < 8; ++i)
#pragma unroll
            for (int j = 0; j < 4; ++j) acc[i][j] = 0.f;
        const bf16* ap = A + (size_t)(pm * 128 + lr) * K + lk; const bf16* bp = Bt + (size_t)(pn * 128 + lr) * K + lk;
        for (int k0 = 0; k0 < K; k0 += 32) {
            const v4u av = *(const v4u*)(ap + k0), bv = *(const v4u*)(bp + k0);
            __syncthreads();
#pragma unroll
            for (int j = 0; j < 4; ++j) {
                As[(lk + 2 * j) * 132 + lr] = __uint_as_float(av[j] << 16); As[(lk + 2 * j + 1) * 132 + lr] = __uint_as_float(av[j] & 0xffff0000u);
                Bs[(lk + 2 * j) * 132 + lr] = __uint_as_float(bv[j] << 16); Bs[(lk + 2 * j + 1) * 132 + lr] = __uint_as_float(bv[j] & 0xffff0000u); }
            __syncthreads();
#pragma unroll 4
            for (int k = 0; k < 32; ++k) {
                const f32x4 a0 = *(const f32x4*)(As + k * 132 + tm * 8), a1 = *(const f32x4*)(As + k * 132 + tm * 8 + 4), b = *(const f32x4*)(Bs + k * 132 + tn * 4);
                const float a[8] = {a0.x, a0.y, a0.z, a0.w, a1.x, a1.y, a1.z, a1.w}; const float bb[4] = {b.x, b.y, b.z, b.w};
#pragma unroll
                for (int i = 0; i < 8; ++i)
#pragma unroll
                    for (int j = 0; j < 4; ++j) acc[i][j] += a[i] * bb[j];
            }
        }
        epi(pm * 128 + tm * 8, pn * 128 + tn * 4, acc);
    }
    __syncthreads();
}

constexpr int GROW = 144;
template <bool OUT>
__device__ __forceinline__ void gla_mfma_pass(Frame& F) {
    const bf16* proj = WSP(bf16, WS_PROJ); const float* LA = WSP(float, WS_ALPHA); bf16* cat = WSP(bf16, WS_CAT);
    float* deltaT = WSP(float, WS_SLOC); float* dec = WSP(float, WS_DEC); const bf16* SBF = WSP(bf16, WS_SBF);
    unsigned char* L = F.lds;
    float* B2 = (float*)L;
    unsigned char* QI = L + 16384;
    unsigned char* KI = L + 25600;
    unsigned char* VT = L + 34816;
    float* SS = (float*)(L + 53248);
    const int tid = F.tid, lane = F.lane, w = F.wave, c32 = lane & 31, hf = lane >> 5;
    const int tt = tid >> 3, c8 = (tid & 7) * 8, e16 = (tid & 7) * 16;
    for (int u = F.vcu; u < 1024; u += F.G) {
        const int bh = u >> 7, ch = u & 127, b = bh >> 2, h = bh & 3; const size_t row0 = (size_t)b * SEQ + ch * 64; const size_t row = row0 + tt;
        const f32x4 l0 = *(const f32x4*)(LA + row * 256 + h * 64 + c8), l1 = *(const f32x4*)(LA + row * 256 + h * 64 + c8 + 4);
        const v4u kk = *(const v4u*)(proj + row * NPJ + C_KG + h * 64 + c8);
        v4u qq = (v4u){0u, 0u, 0u, 0u}; if (OUT) qq = *(const v4u*)(proj + row * NPJ + C_QG + h * 64 + c8);
        const v4u v0 = *(const v4u*)(proj + row * NPJ + C_VG + h * 128 + e16), v1 = *(const v4u*)(proj + row * NPJ + C_VG + h * 128 + e16 + 8);
        __syncthreads();
        *(f32x4*)(B2 + tt * 64 + c8) = l0; *(f32x4*)(B2 + tt * 64 + c8 + 4) = l1;
#pragma unroll
        for (int i = 0; i < 4; ++i) {
            *(unsigned short*)(VT + (e16 + 2 * i) * GROW + tt * 2) = (unsigned short)(v0[i] & 0xffffu); *(unsigned short*)(VT + (e16 + 2 * i + 1) * GROW + tt * 2) = (unsigned short)(v0[i] >> 16);
            *(unsigned short*)(VT + (e16 + 8 + 2 * i) * GROW + tt * 2) = (unsigned short)(v1[i] & 0xffffu); *(unsigned short*)(VT + (e16 + 8 + 2 * i + 1) * GROW + tt * 2) = (unsigned short)(v1[i] >> 16); }
        __syncthreads();
        if (tid < 256) { const int c = tid & 63, q4 = tid >> 6; float a = 0.f;
#pragma unroll
            for (int i = 0; i < 16; ++i) { a += B2[(16 * q4 + i) * 64 + c]; B2[(16 * q4 + i) * 64 + c] = a; } }
        __syncthreads();
        float bv[8], bl[8];
        { const f32x4 x0 = *(const f32x4*)(B2 + tt * 64 + c8), x1 = *(const f32x4*)(B2 + tt * 64 + c8 + 4);
          bv[0] = x0.x; bv[1] = x0.y; bv[2] = x0.z; bv[3] = x0.w; bv[4] = x1.x; bv[5] = x1.y; bv[6] = x1.z; bv[7] = x1.w;
#pragma unroll
          for (int i = 0; i < 8; ++i) bl[i] = 0.f;
#pragma unroll
          for (int q = 0; q < 4; ++q) { const f32x4 t0 = *(const f32x4*)(B2 + (16 * q + 15) * 64 + c8), t1 = *(const f32x4*)(B2 + (16 * q + 15) * 64 + c8 + 4);
              const float tq[8] = {t0.x, t0.y, t0.z, t0.w, t1.x, t1.y, t1.z, t1.w}; const bool before = q < (tt >> 4);
#pragma unroll
              for (int i = 0; i < 8; ++i) { bl[i] += tq[i]; bv[i] += before ? tq[i] : 0.f; } } }
        float kf[8];
#pragma unroll
        for (int i = 0; i < 4; ++i) { kf[2 * i] = __uint_as_float(kk[i] << 16); kf[2 * i + 1] = __uint_as_float(kk[i] & 0xffff0000u); }
        if (!OUT) {
#pragma unroll
            for (int i = 0; i < 8; ++i) { const float ksv = kf[i] * __builtin_amdgcn_exp2f(bl[i] - bv[i]);
                *(unsigned short*)(QI + (c8 + i) * GROW + tt * 2) = (unsigned short)f2bf(ksv); }
            if (tt == 63) {
#pragma unroll
                for (int i = 0; i < 8; ++i) dec[(size_t)u * 64 + c8 + i] = __builtin_amdgcn_exp2f(bl[i]); }
        } else {
            v4u qo, ko;
#pragma unroll
            for (int i = 0; i < 4; ++i) {
                const float q0 = __uint_as_float(qq[i] << 16) * 0.125f * __builtin_amdgcn_exp2f(bv[2 * i]), q1 = __uint_as_float(qq[i] & 0xffff0000u) * 0.125f * __builtin_amdgcn_exp2f(bv[2 * i + 1]);
                const float k0 = kf[2 * i] * __builtin_amdgcn_exp2f(-bv[2 * i]), k1 = kf[2 * i + 1] * __builtin_amdgcn_exp2f(-bv[2 * i + 1]);
                qo[i] = pk2(q0, q1); ko[i] = pk2(k0, k1); }
            *(v4u*)(QI + tt * GROW + c8 * 2) = qo; *(v4u*)(KI + tt * GROW + c8 * 2) = ko;
        }
        __syncthreads();
        if (!OUT) {
            const int eb = w >> 1, cb = w & 1;
            f32x16 acc;
#pragma unroll
            for (int r = 0; r < 16; ++r) acc[r] = 0.f;
#pragma unroll
            for (int s4 = 0; s4 < 4; ++s4) { const bf16x8 af = *(const bf16x8*)(VT + (eb * 32 + c32) * GROW + (16 * s4 + 8 * hf) * 2), bfr = *(const bf16x8*)(QI + (cb * 32 + c32) * GROW + (16 * s4 + 8 * hf) * 2);
                acc = __builtin_amdgcn_mfma_f32_32x32x16_bf16(af, bfr, acc, 0, 0, 0); }
#pragma unroll
            for (int r = 0; r < 16; ++r) { const int e = eb * 32 + (r & 3) + 8 * (r >> 2) + 4 * hf; deltaT[(size_t)u * 8192 + e * 64 + cb * 32 + c32] = acc[r]; }
        } else {
            const int tb = w & 1, eb = w >> 1, t = tb * 32 + c32;
            v2u gg[4];
#pragma unroll
            for (int g4 = 0; g4 < 4; ++g4) gg[g4] = *(const v2u*)(proj + (row0 + t) * NPJ + C_GG + h * 128 + eb * 32 + 8 * g4 + 4 * hf);
            bf16x8 QF[4], SF[4];
#pragma unroll
            for (int s4 = 0; s4 < 4; ++s4) { QF[s4] = *(const bf16x8*)(QI + t * GROW + (16 * s4 + 8 * hf) * 2); SF[s4] = *(const bf16x8*)(SBF + (size_t)u * 8192 + (eb * 32 + c32) * 64 + 16 * s4 + 8 * hf); }
            f32x16 o;
#pragma unroll
            for (int r = 0; r < 16; ++r) o[r] = 0.f;
#pragma unroll
            for (int jb = 0; jb < 2; ++jb) if (jb <= tb) {
                f32x16 at;
#pragma unroll
                for (int r = 0; r < 16; ++r) at[r] = 0.f;
#pragma unroll
                for (int s4 = 0; s4 < 4; ++s4) { const bf16x8 KF = *(const bf16x8*)(KI + (jb * 32 + c32) * GROW + (16 * s4 + 8 * hf) * 2); at = __builtin_amdgcn_mfma_f32_32x32x16_bf16(KF, QF[s4], at, 0, 0, 0); }
                if (jb == tb) {
#pragma unroll
                    for (int r = 0; r < 16; ++r) { const int jl = (r & 3) + 8 * (r >> 2) + 4 * hf; at[r] = (jl <= c32) ? at[r] : 0.f; } }
                v4u pw[2];
#pragma unroll
                for (int r = 0; r < 16; r += 2) pw[r >> 3][(r & 7) >> 1] = pk2(at[r], at[r + 1]);
#pragma unroll
                for (int ks = 0; ks < 2; ++ks) { const unsigned char* vp = VT + (eb * 32 + c32) * GROW + (jb * 32 + 16 * ks + 4 * hf) * 2;
                    const v2u lo = *(const v2u*)vp, hi = *(const v2u*)(vp + 16);
                    const v4u vfw = (v4u){lo.x, lo.y, hi.x, hi.y};
                    o = __builtin_amdgcn_mfma_f32_32x32x16_bf16(__builtin_bit_cast(bf16x8, vfw), __builtin_bit_cast(bf16x8, pw[ks]), o, 0, 0, 0); }
            }
#pragma unroll
            for (int s4 = 0; s4 < 4; ++s4) o = __builtin_amdgcn_mfma_f32_32x32x16_bf16(SF[s4], QF[s4], o, 0, 0, 0);
            float ss = 0.f;
#pragma unroll
            for (int r = 0; r < 16; ++r) ss += o[r] * o[r];
            ss += __shfl_xor(ss, 32);
            if (hf == 0) SS[eb * 64 + t] = ss;
            __syncthreads();
            const float tot = (SS[t] + SS[64 + t]) + (SS[128 + t] + SS[192 + t]);
            const float rn = rsqrtf(tot * (1.0f / 128.0f) + EPS);
#pragma unroll
            for (int g4 = 0; g4 < 4; ++g4) { const int e0 = eb * 32 + 8 * g4 + 4 * hf; const f32x4 gn = *(const f32x4*)(F.gla_g + h * 128 + e0);
                const float ga = __uint_as_float(gg[g4].x << 16), gb = __uint_as_float(gg[g4].x & 0xffff0000u), gc = __uint_as_float(gg[g4].y << 16), gd = __uint_as_float(gg[g4].y & 0xffff0000u);
                const float y0 = o[4 * g4] * rn * gn.x * (ga / (1.f + __expf(-ga))), y1 = o[4 * g4 + 1] * rn * gn.y * (gb / (1.f + __expf(-gb)));
                const float y2 = o[4 * g4 + 2] * rn * gn.z * (gc / (1.f + __expf(-gc))), y3 = o[4 * g4 + 3] * rn * gn.w * (gd / (1.f + __expf(-gd)));
                v2u yo; yo.x = pk2(y0, y1); yo.y = pk2(y2, y3); *(v2u*)(cat + (row0 + t) * DM + h * 128 + e0) = yo; }
        }
    }
    __syncthreads();
}
__device__ __forceinline__ void gla_scan(Frame& F) {
    const float* deltaT = WSP(float, WS_SLOC); const float* dec = WSP(float, WS_DEC); bf16* SBF = WSP(bf16, WS_SBF);
    const int g = F.vcu * NTHR + F.tid;
    if (g >= 65536) return;
    const int bh = g >> 13, ec = g & 8191, c = ec & 63;
    const float* sp = deltaT + (size_t)bh * 128 * 8192 + ec; const float* dp = dec + (size_t)bh * 128 * 64 + c; bf16* op = SBF + (size_t)bh * 128 * 8192 + ec;
    float S = 0.f; float v[8], d[8];
#pragma unroll
    for (int j = 0; j < 8; ++j) { v[j] = sp[(size_t)j * 8192]; d[j] = dp[j * 64]; }
    for (int s0 = 0; s0 < 128; s0 += 8) {
        float vn[8], dn[8];
        const int s1 = (s0 + 8 < 128) ? s0 + 8 : s0;
#pragma unroll
        for (int j = 0; j < 8; ++j) { vn[j] = sp[(size_t)(s1 + j) * 8192]; dn[j] = dp[(s1 + j) * 64]; }
#pragma unroll
        for (int j = 0; j < 8; ++j) { op[(size_t)(s0 + j) * 8192] = (bf16)f2bf(S); S = S * d[j] + v[j]; }
#pragma unroll
        for (int j = 0; j < 8; ++j) { v[j] = vn[j]; d[j] = dn[j]; }
    }
}
__device__ __forceinline__ void ph2_sb_naive(Frame& F) {
    const bf16* proj = WSP(bf16, WS_PROJ); bf16* cat = WSP(bf16, WS_CAT);
    float* Ks = (float*)F.lds; float* Vs = Ks + 32 * 64;
    const int tid = F.tid;
    for (int u = F.vcu; u < 256; u += F.G) {
        const int bh = u >> 4, qb = u & 15, b = bh >> 3, h = bh & 7, t = qb * 512 + tid; const size_t row = (size_t)b * SEQ + t;
        float q[64], o[64];
#pragma unroll
        for (int i = 0; i < 8; ++i) { const v4u w = *(const v4u*)(proj + row * NPJ + C_QS + h * 64 + 8 * i);
#pragma unroll
            for (int j = 0; j < 4; ++j) { q[8 * i + 2 * j] = __uint_as_float(w[j] << 16) * 0.125f; q[8 * i + 2 * j + 1] = __uint_as_float(w[j] & 0xffff0000u) * 0.125f; } }
#pragma unroll
        for (int d = 0; d < 64; ++d) o[d] = 0.f;
        float tail = 0.f;
        for (int kt = (qb * 512 + 511) / 32; kt >= 0; --kt) {
            if (__syncthreads_and(tail < -SB_EXIT_NAT)) break;
            { const int key = tid >> 4, d4 = (tid & 15) * 4; const size_t krow = (size_t)b * SEQ + kt * 32 + key;
              const v2u kk = *(const v2u*)(proj + krow * NPJ + C_KS + h * 64 + d4), vv = *(const v2u*)(proj + krow * NPJ + C_VS + h * 64 + d4);
              *(f32x4*)(Ks + key * 64 + d4) = (f32x4){__uint_as_float(kk.x << 16), __uint_as_float(kk.x & 0xffff0000u), __uint_as_float(kk.y << 16), __uint_as_float(kk.y & 0xffff0000u)};
              *(f32x4*)(Vs + key * 64 + d4) = (f32x4){__uint_as_float(vv.x << 16), __uint_as_float(vv.x & 0xffff0000u), __uint_as_float(vv.y << 16), __uint_as_float(vv.y & 0xffff0000u)}; }
            __syncthreads();
            for (int j = 31; j >= 0; --j) {
                const int s = kt * 32 + j;
                float z = 0.f;
#pragma unroll
                for (int d4 = 0; d4 < 16; ++d4) { const f32x4 k4 = *(const f32x4*)(Ks + j * 64 + 4 * d4); z += q[4 * d4] * k4.x + q[4 * d4 + 1] * k4.y + q[4 * d4 + 2] * k4.z + q[4 * d4 + 3] * k4.w; }
                const bool valid = s < t;
                const float lnb = logsig_neg(z);
                const float w = valid ? expf(z + lnb + tail) : 0.f;
                tail += valid ? lnb : 0.f;
#pragma unroll
                for (int d4 = 0; d4 < 16; ++d4) { const f32x4 v4 = *(const f32x4*)(Vs + j * 64 + 4 * d4); o[4 * d4] += w * v4.x; o[4 * d4 + 1] += w * v4.y; o[4 * d4 + 2] += w * v4.z; o[4 * d4 + 3] += w * v4.w; }
            }
        }
        float ss = 0.f;
#pragma unroll
        for (int d = 0; d < 64; ++d) ss += o[d] * o[d];
        const float r = rsqrtf(ss * (1.0f / 64.0f) + EPS);
#pragma unroll
        for (int i = 0; i < 8; ++i) { v4u w;
#pragma unroll
            for (int j = 0; j < 4; ++j) w[j] = pk2(o[8 * i + 2 * j] * r * F.sb_g[h * 64 + 8 * i + 2 * j], o[8 * i + 2 * j + 1] * r * F.sb_g[h * 64 + 8 * i + 2 * j + 1]);
            *(v4u*)(cat + row * DM + 512 + h * 64 + 8 * i) = w; }
    }
    __syncthreads();
}


constexpr float SB_EXIT_L2 = 44.0f;
__device__ __forceinline__ void ph_sb_mfma(Frame& F) {
    const bf16* proj = WSP(bf16, WS_PROJ); bf16* cat = WSP(bf16, WS_CAT);
    const int lane = F.lane, c = lane & 31, hf = lane >> 5;
    const int gw = F.vcu * NWAVES + F.wave, NGW = F.G * NWAVES;
    f16x8 tri[2];
#pragma unroll
    for (int ks = 0; ks < 2; ++ks)
#pragma unroll
        for (int i = 0; i < 8; ++i) { const int j = 16 * ks + 8 * (i >> 2) + 4 * hf + (i & 3); tri[ks][i] = (j >= c) ? (_Float16)1.0f : (_Float16)0.0f; }
    const float CS = 0.125f * 1.4426950408889634f;
    for (int u = gw; u < 4096; u += NGW) {
        const int bh = u >> 8, qb = u & 255, b = bh >> 3, h = bh & 7, q0 = qb * 32;
        const size_t row0 = (size_t)b * SEQ;
        bf16x8 qf[4];
#pragma unroll
        for (int s4 = 0; s4 < 4; ++s4) qf[s4] = *(const bf16x8*)(proj + (row0 + q0 + c) * NPJ + C_QS + h * 64 + 16 * s4 + 8 * hf);
        f32x16 o0, o1;
#pragma unroll
        for (int r = 0; r < 16; ++r) { o0[r] = 0.f; o1[r] = 0.f; }
        float carry = 0.f;
        for (int kt = qb; kt >= 0; --kt) {
            const int kbase = kt * 32;
            const bf16* kp = proj + (row0 + kbase + c) * NPJ + C_KS + h * 64 + 8 * hf;
            bf16x8 kf[4];
#pragma unroll
            for (int s4 = 0; s4 < 4; ++s4) kf[s4] = *(const bf16x8*)(kp + 16 * s4);
            bf16x8 vf[2][2];
#pragma unroll
            for (int db = 0; db < 2; ++db)
#pragma unroll
                for (int ks = 0; ks < 2; ++ks)
#pragma unroll
                    for (int i = 0; i < 8; ++i) { const int key = 16 * ks + 8 * (i >> 2) + 4 * hf + (i & 3);
                        vf[db][ks][i] = (short)proj[(row0 + kbase + key) * NPJ + C_VS + h * 64 + db * 32 + c]; }
            f32x16 z;
#pragma unroll
            for (int r = 0; r < 16; ++r) z[r] = 0.f;
#pragma unroll
            for (int s4 = 0; s4 < 4; ++s4) z = __builtin_amdgcn_mfma_f32_32x32x16_bf16(kf[s4], qf[s4], z, 0, 0, 0);
            const bool diag = (kt == qb);
            f32x16 cin; f16x8 lb[2];
#pragma unroll
            for (int r = 0; r < 16; ++r) {
                const int kl = (r & 3) + 8 * (r >> 2) + 4 * hf;
                const float z2 = z[r] * CS;
                const float l2 = fmaxf(z2, 0.f) + __builtin_amdgcn_logf(1.0f + __builtin_amdgcn_exp2f(-fabsf(z2)));
                const bool valid = !diag || (kl < c);
                lb[r >> 3][r & 7] = (_Float16)(valid ? -l2 : 0.f);
                cin[r] = z2 + carry;
            }
            f32x16 d = __builtin_amdgcn_mfma_f32_32x32x16_f16(tri[0], lb[0], cin, 0, 0, 0);
            d = __builtin_amdgcn_mfma_f32_32x32x16_f16(tri[1], lb[1], d, 0, 0, 0);
            v4u wb[2];
#pragma unroll
            for (int r = 0; r < 16; r += 2) {
                const int kl0 = (r & 3) + 8 * (r >> 2) + 4 * hf;
                const float w0 = (!diag || (kl0 < c)) ? __builtin_amdgcn_exp2f(d[r]) : 0.f;
                const float w1 = (!diag || (kl0 + 1 < c)) ? __builtin_amdgcn_exp2f(d[r + 1]) : 0.f;
                wb[r >> 3][(r & 7) >> 1] = pk2(w0, w1);
            }
            const bf16x8 wf0 = __builtin_bit_cast(bf16x8, wb[0]), wf1 = __builtin_bit_cast(bf16x8, wb[1]);
            o0 = __builtin_amdgcn_mfma_f32_32x32x16_bf16(vf[0][0], wf0, o0, 0, 0, 0);
            o0 = __builtin_amdgcn_mfma_f32_32x32x16_bf16(vf[0][1], wf1, o0, 0, 0, 0);
            o1 = __builtin_amdgcn_mfma_f32_32x32x16_bf16(vf[1][0], wf0, o1, 0, 0, 0);
            o1 = __builtin_amdgcn_mfma_f32_32x32x16_bf16(vf[1][1], wf1, o1, 0, 0, 0);
            float tot = d[0] - cin[0];
            tot = __shfl(tot, c);
            carry += tot;
            if (__all(carry < -SB_EXIT_L2)) break;
        }
        float ss = 0.f;
#pragma unroll
        for (int r = 0; r < 16; ++r) ss += o0[r] * o0[r] + o1[r] * o1[r];
        ss += __shfl_xor(ss, 32);
        const float rn = rsqrtf(ss * (1.0f / 64.0f) + EPS);
        bf16* op = cat + (row0 + q0 + c) * DM + 512 + h * 64 + 4 * hf;
#pragma unroll
        for (int g = 0; g < 4; ++g) {
            const f32x4 g0 = *(const f32x4*)(F.sb_g + h * 64 + 8 * g + 4 * hf), g1 = *(const f32x4*)(F.sb_g + h * 64 + 32 + 8 * g + 4 * hf);
            v2u a, bq;
            a.x = pk2(o0[4 * g] * rn * g0.x, o0[4 * g + 1] * rn * g0.y); a.y = pk2(o0[4 * g + 2] * rn * g0.z, o0[4 * g + 3] * rn * g0.w);
            bq.x = pk2(o1[4 * g] * rn * g1.x, o1[4 * g + 1] * rn * g1.y); bq.y = pk2(o1[4 * g + 2] * rn * g1.z, o1[4 * g + 3] * rn * g1.w);
            *(v2u*)(op + 8 * g) = a; *(v2u*)(op + 32 + 8 * g) = bq;
        }
    }
}
__device__ __forceinline__ void ph4_ln1(Frame& F) {
    const int gw = F.vcu * NWAVES + F.wave, NGW = F.G * NWAVES;
    float* x1 = WSP(float, WS_X1); bf16* x1b = WSP(bf16, WS_X1B);
    for (int m = gw; m < T; m += NGW) {
        f32x4 y[4]; float s = 0.f;
#pragma unroll
        for (int i = 0; i < 4; ++i) { const size_t o = (size_t)m * DM + 256 * i + 4 * F.lane; y[i] = *(const f32x4*)(F.x + o) * ALPHA + *(const f32x4*)(F.out + o); s += (y[i].x + y[i].y) + (y[i].z + y[i].w); }
        const float mean = wave_sum(s) * (1.0f / DM); float q = 0.f;
#pragma unroll
        for (int i = 0; i < 4; ++i) { y[i] = y[i] - mean; q += (y[i].x * y[i].x + y[i].y * y[i].y) + (y[i].z * y[i].z + y[i].w * y[i].w); }
        const float rstd = rsqrtf(wave_sum(q) * (1.0f / DM) + EPS);
#pragma unroll
        for (int i = 0; i < 4; ++i) { const int c = 256 * i + 4 * F.lane; const size_t o = (size_t)m * DM + c;
            const f32x4 r = y[i] * rstd * *(const f32x4*)(F.ln1_g + c) + *(const f32x4*)(F.ln1_b + c);
            *(f32x4*)(x1 + o) = r; v2u w; w.x = pk2(r.x, r.y); w.y = pk2(r.z, r.w); *(v2u*)(x1b + o) = w; }
    }
}

#define TOPK_INSERT(cv, ci, VAL, IDX) do { float _cv = (cv); int _ci = (ci); \
    _Pragma("unroll") for (int _j = 0; _j < 16; ++_j) { const bool _g = _cv > VAL[_j]; const float _tv = VAL[_j]; const int _ti = IDX[_j]; \
        VAL[_j] = _g ? _cv : _tv; IDX[_j] = _g ? _ci : _ti; _cv = _g ? _tv : _cv; _ci = _g ? _ti : _ci; } } while (0)
__device__ __forceinline__ void ph6_topk_naive(Frame& F) {
    const bf16* qry = WSP(bf16, WS_QRY); const bf16* skb = WSP(bf16, WS_SKB);
    int* pidx = WSP(int, WS_PIDX); float* pgate = WSP(float, WS_PGATE);
    float* sk = (float*)F.lds;
    const int tid = F.tid;
    for (int u = F.vcu; u < 256; u += F.G) {
        const int h = u >> 5, tb = u & 31, t = tb * 512 + tid;
        float sv[2][16]; int si[2][16];
#pragma unroll
        for (int p = 0; p < 2; ++p) {
            __syncthreads();
            for (int i = tid; i < 128 * 128 / 2; i += NTHR) { const unsigned w = *(const unsigned*)(skb + (size_t)(h * 2 + p) * 16384 + 2 * i); sk[2 * i] = __uint_as_float(w << 16); sk[2 * i + 1] = __uint_as_float(w & 0xffff0000u); }
            __syncthreads();
            unsigned qp[64];
#pragma unroll
            for (int i = 0; i < 16; ++i) { const v4u w = *(const v4u*)(qry + (size_t)t * 2048 + h * 256 + p * 128 + 8 * i); qp[4 * i] = w.x; qp[4 * i + 1] = w.y; qp[4 * i + 2] = w.z; qp[4 * i + 3] = w.w; }
#pragma unroll
            for (int j = 0; j < 16; ++j) { sv[p][j] = -INFINITY; si[p][j] = 0; }
            for (int n = 0; n < 128; ++n) {
                float s = 0.f;
#pragma unroll
                for (int c4 = 0; c4 < 32; ++c4) { const f32x4 k4 = *(const f32x4*)(sk + n * 128 + 4 * c4);
                    s += __uint_as_float(qp[2 * c4] << 16) * k4.x + __uint_as_float(qp[2 * c4] & 0xffff0000u) * k4.y + __uint_as_float(qp[2 * c4 + 1] << 16) * k4.z + __uint_as_float(qp[2 * c4 + 1] & 0xffff0000u) * k4.w; }
                TOPK_INSERT(s, n, sv[p], si[p]);
            }
        }
        float bv[16]; int bi[16];
#pragma unroll
        for (int j = 0; j < 16; ++j) { bv[j] = -INFINITY; bi[j] = 0; }
#pragma unroll
        for (int i = 0; i < 16; ++i)
#pragma unroll
            for (int j = 0; j < 16; ++j) TOPK_INSERT(sv[0][i] + sv[1][j], si[0][i] * 128 + si[1][j], bv, bi);
        float den = 0.f; float e[16];
#pragma unroll
        for (int j = 0; j < 16; ++j) { e[j] = expf(bv[j] - bv[0]); den += e[j]; }
        const float inv = 1.0f / den;
#pragma unroll
        for (int j4 = 0; j4 < 4; ++j4) {
            *(f32x4*)(pgate + (size_t)t * 128 + h * 16 + 4 * j4) = (f32x4){e[4 * j4] * inv, e[4 * j4 + 1] * inv, e[4 * j4 + 2] * inv, e[4 * j4 + 3] * inv};
            *(v4u*)(pidx + (size_t)t * 128 + h * 16 + 4 * j4) = (v4u){(unsigned)bi[4 * j4], (unsigned)bi[4 * j4 + 1], (unsigned)bi[4 * j4 + 2], (unsigned)bi[4 * j4 + 3]};
        }
    }
    __syncthreads();
}


__device__ __forceinline__ float vmaxf(float a, float b) { float r; asm("v_max_f32 %0, %1, %2" : "=v"(r) : "v"(a), "v"(b)); return r; }
__device__ __forceinline__ float vminf(float a, float b) { float r; asm("v_min_f32 %0, %1, %2" : "=v"(r) : "v"(a), "v"(b)); return r; }
#define PKINS(cv, L) do { float _c = (cv); _Pragma("unroll") for (int _j = 0; _j < 16; ++_j) { const float _h = vmaxf(L[_j], _c); _c = vminf(L[_j], _c); L[_j] = _h; } } while (0)
__device__ __forceinline__ void ph8_topk(Frame& F) {
    const bf16* qry = WSP(bf16, WS_QRY); const bf16* skb = WSP(bf16, WS_SKB);
    int* pidx = WSP(int, WS_PIDX); float* pgate = WSP(float, WS_PGATE);
    const int lane = F.lane, c = lane & 31, hf = lane >> 5; const unsigned hf4 = (unsigned)hf << 2;
    float* wl = (float*)F.lds + F.wave * 1056 + c * 33;
    const int gw = F.vcu * NWAVES + F.wave, NGW = F.G * NWAVES;
    const float NINF = __uint_as_float(0xff800000u);
    for (int u = gw; u < 4096; u += NGW) {
        const int h = u >> 9, t = (u & 511) * 32 + c;
        float LA[16], LB[16];
#pragma unroll
        for (int p = 0; p < 2; ++p) {
            float L[16];
#pragma unroll
            for (int j = 0; j < 16; ++j) L[j] = NINF;
            bf16x8 qf[8];
#pragma unroll
            for (int s8 = 0; s8 < 8; ++s8) qf[s8] = *(const bf16x8*)(qry + (size_t)t * 2048 + h * 256 + p * 128 + 16 * s8 + 8 * hf);
#pragma unroll
            for (int kb = 0; kb < 4; ++kb) {
                const bf16* kp = skb + ((size_t)(h * 2 + p) * 128 + kb * 32 + c) * 128 + 8 * hf;
                f32x16 z;
#pragma unroll
                for (int r = 0; r < 16; ++r) z[r] = 0.f;
#pragma unroll
                for (int s8 = 0; s8 < 8; ++s8) { const bf16x8 kf = *(const bf16x8*)(kp + 16 * s8); z = __builtin_amdgcn_mfma_f32_32x32x16_bf16(kf, qf[s8], z, 0, 0, 0); }
#pragma unroll
                for (int r = 0; r < 16; ++r) { const unsigned n = (unsigned)(kb * 32 + (r & 3) + 8 * (r >> 2));
                    const float pk = __uint_as_float(((__float_as_uint(z[r]) & 0xffffff80u) | hf4) | n); PKINS(pk, L); }
            }
            float P[16];
#pragma unroll
            for (int j = 0; j < 16; ++j) P[j] = __shfl_xor(L[j], 32);
#pragma unroll
            for (int j = 0; j < 16; ++j) PKINS(P[j], L);
#pragma unroll
            for (int j = 0; j < 16; ++j) { if (p == 0) LA[j] = L[j]; else LB[j] = L[j]; }
        }
        float best[16];
#pragma unroll
        for (int j = 0; j < 16; ++j) best[j] = NINF;
#pragma unroll
        for (int i = 0; i < 16; ++i)
#pragma unroll
            for (int j = 0; j < 16; ++j) if ((i + 1) * (j + 1) <= 16) { const float sm = LA[i] + LB[j];
                const float pk = __uint_as_float((__float_as_uint(sm) & 0xffffff00u) | (unsigned)(i * 16 + j)); PKINS(pk, best); }
        asm volatile("s_waitcnt lgkmcnt(0)" ::: "memory");
#pragma unroll
        for (int j = 0; j < 16; ++j) wl[16 * hf + j] = hf ? LB[j] : LA[j];
        asm volatile("s_waitcnt lgkmcnt(0)" ::: "memory");
        const float mx = __uint_as_float(__float_as_uint(best[0]) & 0xffffff00u);
        float ev[8]; unsigned id[8]; float sum = 0.f;
#pragma unroll
        for (int k = 0; k < 8; ++k) { const unsigned bk = __float_as_uint(hf ? best[k + 8] : best[k]); const unsigned code = bk & 255u;
            const unsigned ia = __float_as_uint(wl[code >> 4]) & 127u, ib = __float_as_uint(wl[16 + (code & 15u)]) & 127u; id[k] = ia * 128u + ib;
            ev[k] = __expf(__uint_as_float(bk & 0xffffff00u) - mx); sum += ev[k]; }
        sum += __shfl_xor(sum, 32);
        const float inv = 1.0f / sum;
        float* gp = pgate + (size_t)t * 128 + h * 16 + 8 * hf; int* ip = pidx + (size_t)t * 128 + h * 16 + 8 * hf;
        *(f32x4*)gp = (f32x4){ev[0] * inv, ev[1] * inv, ev[2] * inv, ev[3] * inv}; *(f32x4*)(gp + 4) = (f32x4){ev[4] * inv, ev[5] * inv, ev[6] * inv, ev[7] * inv};
        *(v4u*)ip = (v4u){id[0], id[1], id[2], id[3]}; *(v4u*)(ip + 4) = (v4u){id[4], id[5], id[6], id[7]};
        asm volatile("s_waitcnt lgkmcnt(0)" ::: "memory");
    }
}
__device__ __forceinline__ void ph7_peer_naive(Frame& F) {
    const int gw = F.vcu * NWAVES + F.wave, NGW = F.G * NWAVES;
    const float* x1 = WSP(float, WS_X1); const int* pidx = WSP(int, WS_PIDX); const float* pgate = WSP(float, WS_PGATE);
    for (int m = gw; m < T; m += NGW) {
        f32x4 xv[4], acc[4];
#pragma unroll
        for (int i = 0; i < 4; ++i) { xv[i] = *(const f32x4*)(x1 + (size_t)m * DM + 256 * i + 4 * F.lane); acc[i] = (f32x4){0.f, 0.f, 0.f, 0.f}; }
        for (int k = 0; k < 128; ++k) {
            const int e = __builtin_amdgcn_readfirstlane(pidx[(size_t)m * 128 + k]); const float g = pgate[(size_t)m * 128 + k];
            const float* ur = F.pu + (size_t)e * DM; const float* vr = F.pv + (size_t)e * DM;
            float p = 0.f;
#pragma unroll
            for (int i = 0; i < 4; ++i) { const f32x4 uu = *(const f32x4*)(ur + 256 * i + 4 * F.lane); p += (uu.x * xv[i].x + uu.y * xv[i].y) + (uu.z * xv[i].z + uu.w * xv[i].w); }
            p = wave_sum(p);
            const float w = g * 0.5f * p * (1.0f + erff(p * 0.70710678118654752f));
#pragma unroll
            for (int i = 0; i < 4; ++i) acc[i] += *(const f32x4*)(vr + 256 * i + 4 * F.lane) * w;
        }
        float s = 0.f;
#pragma unroll
        for (int i = 0; i < 4; ++i) { acc[i] = xv[i] * ALPHA + acc[i]; s += (acc[i].x + acc[i].y) + (acc[i].z + acc[i].w); }
        const float mean = wave_sum(s) * (1.0f / DM); float q = 0.f;
#pragma unroll
        for (int i = 0; i < 4; ++i) { acc[i] = acc[i] - mean; q += (acc[i].x * acc[i].x + acc[i].y * acc[i].y) + (acc[i].z * acc[i].z + acc[i].w * acc[i].w); }
        const float rstd = rsqrtf(wave_sum(q) * (1.0f / DM) + EPS);
#pragma unroll
        for (int i = 0; i < 4; ++i) { const int c = 256 * i + 4 * F.lane;
            *(f32x4*)(F.out + (size_t)m * DM + c) = acc[i] * rstd * *(const f32x4*)(F.ln2_g + c) + *(const f32x4*)(F.ln2_b + c); }
    }
}


__device__ __forceinline__ float gelu_erf(float p) { return 0.5f * p * (1.0f + erff(p * 0.70710678118654752f)); }
__device__ __forceinline__ void ph7_peer(Frame& F) {
    const int gw = F.vcu * NWAVES + F.wave, NGW = F.G * NWAVES, lane = F.lane;
    const float* x1 = WSP(float, WS_X1); const int* pidx = WSP(int, WS_PIDX); const float* pgate = WSP(float, WS_PGATE);
    const bf16* UB = WSP(bf16, WS_UB); const bf16* VB = WSP(bf16, WS_VB);
    const bool b5 = (lane & 32) != 0, b4 = (lane & 16) != 0, b3 = (lane & 8) != 0;
    for (int m = gw; m < T; m += NGW) {
        float xv[16], acc[16];
#pragma unroll
        for (int i = 0; i < 2; ++i) { const f32x4 a = *(const f32x4*)(x1 + (size_t)m * DM + 512 * i + 8 * lane), b = *(const f32x4*)(x1 + (size_t)m * DM + 512 * i + 8 * lane + 4);
            xv[8 * i] = a.x; xv[8 * i + 1] = a.y; xv[8 * i + 2] = a.z; xv[8 * i + 3] = a.w; xv[8 * i + 4] = b.x; xv[8 * i + 5] = b.y; xv[8 * i + 6] = b.z; xv[8 * i + 7] = b.w; }
#pragma unroll
        for (int i = 0; i < 16; ++i) acc[i] = 0.f;
        for (int k0 = 0; k0 < 128; k0 += 8) {
            const int ei = pidx[(size_t)m * 128 + k0 + (lane >> 3)]; const float gi = pgate[(size_t)m * 128 + k0 + (lane >> 3)];
            v4u uw[8][2], vw[8][2];
#pragma unroll
            for (int j = 0; j < 8; ++j) { const int e = __builtin_amdgcn_readlane(ei, 8 * j);
#pragma unroll
                for (int i = 0; i < 2; ++i) { uw[j][i] = *(const v4u*)(UB + (size_t)e * DM + 512 * i + 8 * lane); vw[j][i] = *(const v4u*)(VB + (size_t)e * DM + 512 * i + 8 * lane); } }
            float p[8];
#pragma unroll
            for (int j = 0; j < 8; ++j) { float a = 0.f;
#pragma unroll
                for (int i = 0; i < 2; ++i)
#pragma unroll
                    for (int q = 0; q < 4; ++q) { const unsigned w = uw[j][i][q]; a += __uint_as_float(w << 16) * xv[8 * i + 2 * q] + __uint_as_float(w & 0xffff0000u) * xv[8 * i + 2 * q + 1]; }
                p[j] = a; }
            float r1[4], r2[2];
#pragma unroll
            for (int j = 0; j < 4; ++j) r1[j] = (b5 ? p[j + 4] : p[j]) + __shfl_xor(b5 ? p[j] : p[j + 4], 32);
#pragma unroll
            for (int j = 0; j < 2; ++j) r2[j] = (b4 ? r1[j + 2] : r1[j]) + __shfl_xor(b4 ? r1[j] : r1[j + 2], 16);
            float r3 = (b3 ? r2[1] : r2[0]) + __shfl_xor(b3 ? r2[0] : r2[1], 8);
            r3 += __shfl_xor(r3, 4); r3 += __shfl_xor(r3, 2); r3 += __shfl_xor(r3, 1);
            const float wl = gi * gelu_erf(r3);
#pragma unroll
            for (int j = 0; j < 8; ++j) { const float w = __int_as_float(__builtin_amdgcn_readlane(__float_as_int(wl), 8 * j));
#pragma unroll
                for (int i = 0; i < 2; ++i)
#pragma unroll
                    for (int q = 0; q < 4; ++q) { const unsigned vwd = vw[j][i][q]; acc[8 * i + 2 * q] += w * __uint_as_float(vwd << 16); acc[8 * i + 2 * q + 1] += w * __uint_as_float(vwd & 0xffff0000u); } }
        }
        float s = 0.f;
#pragma unroll
        for (int i = 0; i < 16; ++i) { acc[i] = xv[i] * ALPHA + acc[i]; s += acc[i]; }
        const float mean = wave_sum(s) * (1.0f / DM); float q = 0.f;
#pragma unroll
        for (int i = 0; i < 16; ++i) { acc[i] -= mean; q += acc[i] * acc[i]; }
        const float rstd = rsqrtf(wave_sum(q) * (1.0f / DM) + EPS);
#pragma unroll
        for (int i = 0; i < 2; ++i)
#pragma unroll
            for (int hh = 0; hh < 2; ++hh) { const int c = 512 * i + 8 * lane + 4 * hh; const f32x4 g = *(const f32x4*)(F.ln2_g + c), bb = *(const f32x4*)(F.ln2_b + c);
                *(f32x4*)(F.out + (size_t)m * DM + c) = (f32x4){acc[8 * i + 4 * hh] * rstd * g.x + bb.x, acc[8 * i + 4 * hh + 1] * rstd * g.y + bb.y, acc[8 * i + 4 * hh + 2] * rstd * g.z + bb.z, acc[8 * i + 4 * hh + 3] * rstd * g.w + bb.w}; }
    }
}

__device__ __forceinline__ void ph9_peer_fp8(Frame& F) {
    const int gw = F.vcu * NWAVES + F.wave, NGW = F.G * NWAVES, lane = F.lane;
    const float* x1 = WSP(float, WS_X1); const int* pidx = WSP(int, WS_PIDX); const float* pgate = WSP(float, WS_PGATE);
    const unsigned char* U8 = F.ws + WS_U8; const unsigned char* V8 = F.ws + WS_V8; const float* rsu = WSP(float, WS_RSU); const float* rsv = WSP(float, WS_RSV);
    const bool b5 = (lane & 32) != 0, b4 = (lane & 16) != 0, b3 = (lane & 8) != 0, b2 = (lane & 4) != 0;
    for (int m = gw; m < T; m += NGW) {
        f32x2 xv[8], acc[8];
#pragma unroll
        for (int i = 0; i < 4; ++i) { const f32x4 a = *(const f32x4*)(x1 + (size_t)m * DM + 16 * lane + 4 * i); xv[2 * i] = (f32x2){a.x, a.y}; xv[2 * i + 1] = (f32x2){a.z, a.w}; }
#pragma unroll
        for (int i = 0; i < 8; ++i) acc[i] = (f32x2){0.f, 0.f};
        for (int k0 = 0; k0 < 128; k0 += 16) {
            const int ei = pidx[(size_t)m * 128 + k0 + (lane >> 2)]; const float gi = pgate[(size_t)m * 128 + k0 + (lane >> 2)];
            const float su = rsu[ei], sv = rsv[ei];
            v4u uw[16], vw[16];
#pragma unroll
            for (int j = 0; j < 16; ++j) { const int e = __builtin_amdgcn_readlane(ei, 4 * j);
                uw[j] = *(const v4u*)(U8 + (size_t)e * DM + 16 * lane); vw[j] = *(const v4u*)(V8 + (size_t)e * DM + 16 * lane); }
            float p[16];
#pragma unroll
            for (int j = 0; j < 16; ++j) { f32x2 a = (f32x2){0.f, 0.f};
#pragma unroll
                for (int q = 0; q < 4; ++q) { a += __builtin_amdgcn_cvt_pk_f32_fp8((int)uw[j][q], false) * xv[2 * q]; a += __builtin_amdgcn_cvt_pk_f32_fp8((int)uw[j][q], true) * xv[2 * q + 1]; }
                p[j] = a.x + a.y; }
            float r1[8], r2[4], r3[2];
#pragma unroll
            for (int j = 0; j < 8; ++j) r1[j] = (b5 ? p[j + 8] : p[j]) + __shfl_xor(b5 ? p[j] : p[j + 8], 32);
#pragma unroll
            for (int j = 0; j < 4; ++j) r2[j] = (b4 ? r1[j + 4] : r1[j]) + __shfl_xor(b4 ? r1[j] : r1[j + 4], 16);
#pragma unroll
            for (int j = 0; j < 2; ++j) r3[j] = (b3 ? r2[j + 2] : r2[j]) + __shfl_xor(b3 ? r2[j] : r2[j + 2], 8);
            float r4 = (b2 ? r3[1] : r3[0]) + __shfl_xor(b2 ? r3[0] : r3[1], 4);
            r4 += __shfl_xor(r4, 2); r4 += __shfl_xor(r4, 1);
            const float wl = gi * gelu_erf(r4 * su) * sv;
#pragma unroll
            for (int j = 0; j < 16; ++j) { const float w = __int_as_float(__builtin_amdgcn_readlane(__float_as_int(wl), 4 * j)); const f32x2 w2 = (f32x2){w, w};
#pragma unroll
                for (int q = 0; q < 4; ++q) { acc[2 * q] += __builtin_amdgcn_cvt_pk_f32_fp8((int)vw[j][q], false) * w2; acc[2 * q + 1] += __builtin_amdgcn_cvt_pk_f32_fp8((int)vw[j][q], true) * w2; } }
        }
        float s = 0.f;
#pragma unroll
        for (int i = 0; i < 8; ++i) { acc[i] = xv[i] * ALPHA + acc[i]; s += acc[i].x + acc[i].y; }
        const float mean = wave_sum(s) * (1.0f / DM); float q = 0.f;
#pragma unroll
        for (int i = 0; i < 8; ++i) { acc[i] = acc[i] - mean; q += acc[i].x * acc[i].x + acc[i].y * acc[i].y; }
        const float rstd = rsqrtf(wave_sum(q) * (1.0f / DM) + EPS);
#pragma unroll
        for (int i = 0; i < 4; ++i) { const int c = 16 * lane + 4 * i; const f32x4 g = *(const f32x4*)(F.ln2_g + c), bb = *(const f32x4*)(F.ln2_b + c);
            *(f32x4*)(F.out + (size_t)m * DM + c) = (f32x4){acc[2 * i].x * rstd * g.x + bb.x, acc[2 * i].y * rstd * g.y + bb.y, acc[2 * i + 1].x * rstd * g.z + bb.z, acc[2 * i + 1].y * rstd * g.w + bb.w}; }
    }
}
struct Args { const float* in[15]; float* out; unsigned char* ws; int ph_lo, ph_hi, li, pad; };
__global__ void __launch_bounds__(NTHR, 2) mk_fwd(Args args) {
    extern __shared__ __attribute__((aligned(16))) unsigned char lds[];
    Frame F;
    F.lds = lds; F.tid = threadIdx.x; F.lane = F.tid & 63; F.wave = __builtin_amdgcn_readfirstlane(F.tid >> 6);
    F.G = gridDim.x; { const int bx = blockIdx.x; F.vcu = (F.G % 8 == 0) ? (bx % 8) * (F.G / 8) + bx / 8 : bx; }
    F.x = args.in[0]; F.w_in = args.in[1]; F.w_gate = args.in[2]; F.b_gate = args.in[3]; F.gla_g = args.in[4]; F.sb_g = args.in[5]; F.w_out = args.in[6];
    F.ln1_g = args.in[7]; F.ln1_b = args.in[8]; F.w_q = args.in[9]; F.sub_keys = args.in[10]; F.pu = args.in[11]; F.pv = args.in[12]; F.ln2_g = args.in[13]; F.ln2_b = args.in[14];
    F.out = args.out; F.ws = args.ws;
    volatile LAS unsigned* MISC = (volatile LAS unsigned*)((LAS unsigned char*)lds + MISC_OFF);
    if (F.tid < 32) MISC[F.tid] = 0u;
    __syncthreads();
    unsigned* barw = (unsigned*)(F.ws + WS_CTL) + CW_BAR + args.li * XCD_BAR_WORDS;
    XcdBarrier bar; bar.bar = barw; bar.x = 0; bar.st = nullptr;
    const int lo = args.ph_lo, hi = args.ph_hi;
    if (hi - lo > 1) bar = xcd_barrier_post(barw, MISC + 8);
#ifndef PH_MASK
#define PH_MASK 0x3ff
#endif
#define IN(k) (((PH_MASK >> (k)) & 1) && lo <= (k) && (k) < hi)
#ifndef REP_PHASE
#define REP_PHASE -1
#endif
#ifndef REP_N
#define REP_N 2
#endif
#define SEAM(k) do { if (IN(k) && IN((k) + 1)) xcd_barrier(bar); } while (0)
#ifndef NAIVE_MASK
#define NAIVE_MASK 0x00
#endif
#define NV(k) ((NAIVE_MASK >> (k)) & 1)
    LAS unsigned char* const ldsl = (LAS unsigned char*)lds;
#define PH0 ph0_prologue(F)
#define PH1 do { pg8::Gemm g{WSP(bf16, WS_XB), WSP(bf16, WS_WTIN), T, NPJ, DM}; pg8::StaticOrder S; S.init(T, NPJ, F.G, (int)blockIdx.x); \
        pg8::EpiBf16<0> E{WSP(bf16, WS_PROJ), NPJ, nullptr, 0, 0, 1.f}; pg8::gemm_phase<pg8::EpiBf16<0>, pg8::StaticOrder, true, true>(ldsl, g, S, E); } while (0)
#define PH2 do { gla_mfma_pass<false>(F); ph_sb_mfma(F); } while (0)
#define PH3 gla_scan(F)
#define PH4 gla_mfma_pass<true>(F)
#define PH5 do { pg8::Gemm g{WSP(bf16, WS_CAT), WSP(bf16, WS_WTOUT), T, DM, DM}; pg8::StaticOrder S; S.init(T, DM, F.G, (int)blockIdx.x); \
        pg8::EpiF32 E{F.out, DM}; pg8::gemm_phase<pg8::EpiF32, pg8::StaticOrder, true, true>(ldsl, g, S, E); } while (0)
#define PH6 ph4_ln1(F)
#define PH7 do { pg8::Gemm g{WSP(bf16, WS_X1B), WSP(bf16, WS_WTQ), T, 2048, DM}; pg8::StaticOrder S; S.init(T, 2048, F.G, (int)blockIdx.x); \
        pg8::EpiBf16<0> E{WSP(bf16, WS_QRY), 2048, nullptr, 0, 0, 1.f}; pg8::gemm_phase<pg8::EpiBf16<0>, pg8::StaticOrder, true, true>(ldsl, g, S, E); } while (0)
#define PH8 ph8_topk(F)
#define PH9 ph9_peer_fp8(F)
#define RUN(k, BODY) do { if (IN(k)) { BODY; if (REP_PHASE == (k)) { for (int rep_ = 0; rep_ < REP_N; ++rep_) { xcd_barrier(bar); BODY; } } } } while (0)
    RUN(0, PH0); SEAM(0);
    RUN(1, PH1); SEAM(1);
    RUN(2, PH2); SEAM(2);
    RUN(3, PH3); SEAM(3);
    RUN(4, PH4); SEAM(4);
    RUN(5, PH5); SEAM(5);
    RUN(6, PH6); SEAM(6);
    RUN(7, PH7); SEAM(7);
    RUN(8, PH8); SEAM(8);
    RUN(9, PH9);
#undef IN
#undef SEAM
}

extern "C" void kernel_launch(void* const* d_in, const int* in_sizes, int n_in, void* d_out, int out_size, void* d_ws, size_t ws_size, hipStream_t stream) {
    static int grid = 0;
    if (grid == 0) {
        if (n_in != 15 || in_sizes[0] != T * DM || out_size != T * DM || ws_size < WS_END) {
            fprintf(stderr, "kernel_launch: unexpected problem: n_in %d in0 %d out %d ws %zu (need %zu)\n", n_in, n_in > 0 ? in_sizes[0] : -1, out_size, ws_size, (size_t)WS_END); grid = -1; return; }
        int dev = 0, cus = 0;
        if (hipGetDevice(&dev) != hipSuccess || hipDeviceGetAttribute(&cus, hipDeviceAttributeMultiprocessorCount, dev) != hipSuccess) { grid = -1; return; }
        if (hipFuncSetAttribute((const void*)mk_fwd, hipFuncAttributeMaxDynamicSharedMemorySize, LDS_BYTES) != hipSuccess) { fprintf(stderr, "kernel_launch: hipFuncSetAttribute failed\n"); grid = -1; return; }
        (void)hipGetLastError();
        grid = cus;
    }
    if (grid < 0) return;
    if (hipMemsetAsync((char*)d_ws + WS_CTL, 0, CTL_ZERO_BYTES, stream) != hipSuccess) { fprintf(stderr, "kernel_launch: memset failed\n"); return; }
    Args a{};
    for (int i = 0; i < 15; ++i) a.in[i] = (const float*)d_in[i];
    a.out = (float*)d_out; a.ws = (unsigned char*)d_ws;
    constexpr int NL = MK_N_LAUNCHES;
    for (int li = 0; li < NL; ++li) {
        a.ph_lo = (NL == 1) ? 0 : li; a.ph_hi = (NL == 1) ? NPHASE : li + 1; a.li = li;
        hipLaunchKernelGGL(mk_fwd, dim3(grid), dim3(NTHR), LDS_BYTES, stream, a);
        const hipError_t le = hipPeekAtLastError();
        if (le != hipSuccess) { fprintf(stderr, "kernel_launch: launch %d failed: %s\n", li, hipGetErrorName(le)); break; }
    }
}
```

```cpp
#include <hip/hip_runtime.h>
#include <cstdio>
#include <cstdint>

#ifndef MK_N_LAUNCHES
#define MK_N_LAUNCHES 1
#endif

#define GAS __attribute__((address_space(1)))
#define LAS __attribute__((address_space(3)))
typedef unsigned short bf16;
typedef unsigned v4u __attribute__((ext_vector_type(4)));
typedef unsigned v2u __attribute__((ext_vector_type(2)));
typedef float f32x4 __attribute__((ext_vector_type(4)));
typedef float f32x2 __attribute__((ext_vector_type(2)));
typedef short bf16x8 __attribute__((ext_vector_type(8)));
typedef _Float16 f16x8 __attribute__((ext_vector_type(8)));
typedef float f32x16 __attribute__((ext_vector_type(16)));

constexpr int BATCH = 2, SEQ = 8192, DM = 1024, T = BATCH * SEQ;
constexpr int INW = 3088, NPJ = 3072;
constexpr int C_QG = 0, C_KG = 256, C_VG = 512, C_GG = 1024, C_QS = 1536, C_KS = 2048, C_VS = 2560;
constexpr int A_COL = 1536;
constexpr float ALPHA = 1.18920711500272f;
constexpr float EPS = 1e-5f;
constexpr int NWAVES = 8, NTHR = 512;
constexpr int NPHASE = 10;
constexpr float SB_EXIT_NAT = 30.0f;

constexpr size_t MiB = 1u << 20;
constexpr size_t WS_CTL = 0, CTL_ZERO_BYTES = 1 * MiB;
constexpr size_t WS_WTIN = 1 * MiB;
constexpr size_t WS_WTOUT = 7 * MiB;
constexpr size_t WS_WTQ = 9 * MiB;
constexpr size_t WS_SKB = 13 * MiB;
constexpr size_t WS_UB = 14 * MiB;
constexpr size_t WS_VB = 46 * MiB;
constexpr size_t WS_U8 = 14 * MiB;
constexpr size_t WS_V8 = 30 * MiB;
constexpr size_t WS_RSU = 46 * MiB;
constexpr size_t WS_RSV = 46 * MiB + 65536;
constexpr size_t WS_PROJ = 78 * MiB;
constexpr size_t WS_X1 = 78 * MiB, WS_X1B = 142 * MiB;
constexpr size_t WS_XB = 174 * MiB;
constexpr size_t WS_QRY = 174 * MiB;
constexpr size_t WS_CAT = 206 * MiB;
constexpr size_t WS_ST = 238 * MiB;
constexpr size_t WS_PIDX = 238 * MiB, WS_PGATE = 246 * MiB;
constexpr size_t WS_ALPHA = 238 * MiB;
constexpr size_t WS_SLOC = 174 * MiB;
constexpr size_t WS_DEC = 254 * MiB;
constexpr size_t WS_SBF = 48 * MiB;
constexpr size_t WS_END = 255 * MiB + 512 * 1024;

constexpr int CW_BAR = 4096;

constexpr int LDS_BYTES = 147456;
constexpr int MISC_OFF = 140 * 1024;

__device__ __forceinline__ float bf2f(unsigned v) { return __uint_as_float(v << 16); }
__device__ __forceinline__ unsigned f2bf(float f) { unsigned u = __float_as_uint(f); return (u + 0x7fffu + ((u >> 16) & 1u)) >> 16; }
__device__ __forceinline__ unsigned pk2(float lo, float hi) { return f2bf(lo) | (f2bf(hi) << 16); }
__device__ __forceinline__ float wave_sum(float v) {
#pragma unroll
    for (int o = 1; o < 64; o <<= 1) v += __shfl_xor(v, o);
    return v;
}
__device__ __forceinline__ float logsig_neg(float z) {
    return -(fmaxf(z, 0.f) + log1pf(expf(-fabsf(z))));
}

#define XB_TMO      128
#define XB_XCNT(j)  (256  + 64 * (j))
#define XB_XSUB(j)  (1280 + 64 * (j))
#define XB_XGEN(j)  (2304 + 64 * (j))
#define XB_TOP      3328
#define XB_TOPGEN   3392
#define XCD_BAR_WORDS 3456
#define XB_SPIN_CAP (1u << 23)
__device__ __forceinline__ unsigned xb_ld(unsigned* p)              { return __hip_atomic_load(p, __ATOMIC_RELAXED, __HIP_MEMORY_SCOPE_AGENT); }
__device__ __forceinline__ unsigned xb_add(unsigned* p, unsigned v) { return __hip_atomic_fetch_add(p, v, __ATOMIC_RELAXED, __HIP_MEMORY_SCOPE_AGENT); }
__device__ __forceinline__ unsigned xb_xcc_id() { return (unsigned)__builtin_amdgcn_s_getreg((3 << 11) | 20) & 0xFu; }
#define XB_SPIN(cond, bar) do { unsigned _sp = 0; while (cond) { __builtin_amdgcn_s_sleep(1); \
    if ((++_sp & 255u) == 0u) { if (xb_ld(&(bar)[XB_TMO])) break; if (_sp > XB_SPIN_CAP) { atomicAdd(&(bar)[XB_TMO], 1u); break; } } } } while (0)
struct XcdBarrier { unsigned* bar; unsigned x; volatile LAS unsigned* st; };
__device__ __forceinline__ XcdBarrier xcd_barrier_post(unsigned* bar, volatile LAS unsigned* st) {
    XcdBarrier b; b.bar = bar; b.x = xb_xcc_id(); b.st = st;
    if (threadIdx.x == 0) (void)xb_add(&bar[XB_XCNT(b.x)], 1u);
    return b;
}
__device__ __forceinline__ void xcd_barrier_complete(unsigned* bar, unsigned x, unsigned& nloc, unsigned& nx) {
    const unsigned G = gridDim.x * gridDim.y * gridDim.z;
    unsigned sum, cnt, mine, sp = 0u;
    for (;;) {
        sum = 0u; cnt = 0u; mine = 0u;
#pragma unroll
        for (unsigned j = 0; j < 16; ++j) { const unsigned c = xb_ld(&bar[XB_XCNT(j)]); sum += c; cnt += (c > 0u) ? 1u : 0u; mine = (j == x) ? c : mine; }
        if (sum == G) break;
        __builtin_amdgcn_s_sleep(1);
        if ((++sp & 255u) == 0u) { if (xb_ld(&bar[XB_TMO])) break; if (sp > XB_SPIN_CAP) { atomicAdd(&bar[XB_TMO], 1u); break; } }
    }
    nloc = mine > 0u ? mine : 1u; nx = cnt > 0u ? cnt : 1u;
}
__device__ __forceinline__ void xcd_barrier(const XcdBarrier& b) {
    asm volatile("s_waitcnt vmcnt(0)" ::: "memory");
    __syncthreads();
    if (threadIdx.x == 0) {
        unsigned* bar = b.bar;
        __builtin_amdgcn_s_waitcnt(0);
        unsigned nloc = b.st[0], nx = b.st[1];
        if (nloc == 0u) { xcd_barrier_complete(bar, b.x, nloc, nx); b.st[0] = nloc; b.st[1] = nx; }
        const unsigned old = xb_add(&bar[XB_XSUB(b.x)], 1u);
        const unsigned gen = old / nloc;
        if (old + 1u == (gen + 1u) * nloc) {
            __builtin_amdgcn_fence(__ATOMIC_RELEASE, "agent");
            asm volatile("s_waitcnt vmcnt(0)" ::: "memory");
            const unsigned og = xb_add(&bar[XB_TOP], 1u);
            const unsigned tg = og / nx;
            if (og + 1u == (tg + 1u) * nx) xb_add(&bar[XB_TOPGEN], 1u);
            else XB_SPIN(xb_ld(&bar[XB_TOPGEN]) == tg, bar);
            __builtin_amdgcn_fence(__ATOMIC_ACQUIRE, "agent");
            xb_add(&bar[XB_XGEN(b.x)], 1u);
            asm volatile("s_waitcnt vmcnt(0)" ::: "memory");
        } else {
            XB_SPIN(xb_ld(&bar[XB_XGEN(b.x)]) == gen, bar);
            __builtin_amdgcn_fence(__ATOMIC_ACQUIRE, "agent");
            asm volatile("s_waitcnt vmcnt(0)" ::: "memory");
        }
    }
    __syncthreads();
}

namespace pg8 {
#define PG8_LAS __attribute__((address_space(3)))
typedef unsigned short bf16_t;
typedef short bf16x8 __attribute__((ext_vector_type(8)));
typedef float f32x4 __attribute__((ext_vector_type(4)));
typedef unsigned u32x4 __attribute__((ext_vector_type(4)));
constexpr int BM = 256, BK = 64, HALF = 128, HTB = HALF * BK * 2  , STAGE_BYTES = 8 * HTB, NXCD = 8, WGM = 8;

__host__ __device__ __forceinline__ int lds_byte(int r, int c) { const int st = (r >> 4) * 2 + (c >> 5), rr = r & 15, cc = c & 31, ob = rr * 64 + cc * 2; return st * 1024 + (ob ^ (((ob >> 9) & 1) << 5)); }
__host__ __device__ __forceinline__ void stage_rc(int b, int& R, int& C) { const int st = b / 1024, sb = b % 1024, swz = sb ^ (((sb >> 9) & 1) << 5); R = (st >> 1) * 16 + swz / 64; C = (st & 1) * 32 + (swz % 64) / 2; }
__host__ __device__ __forceinline__ int perm32(int rho) { const int n = rho >> 4, i = rho & 15; return 8 * (i >> 2) + 4 * n + (i & 3); }

struct Unit { int pm, pn; };
struct Gemm { const bf16_t* A; const bf16_t* Bt; int M, N, K; };

struct StaticOrder {
    int nM, nN, nwg, G, c;
    __host__ __device__ void init(int M, int N, int G_, int c_) { nM = M / BM; nN = N / BM; nwg = nM * nN; G = G_; c = c_; }
    __host__ __device__ bool next(int i, Unit& u) const {
        const long L = (long)i * G + c; if (L >= nwg) return false;
        int wgid = (int)L; { const int q = nwg / NXCD, r = nwg % NXCD, xcd = wgid % NXCD, off = wgid / NXCD; wgid = (xcd < r ? xcd * (q + 1) : r * (q + 1) + (xcd - r) * q) + off; }
        const int nig = WGM * nN, gid = wgid / nig, fm = gid * WGM, gsz = (nM - fm) < WGM ? (nM - fm) : WGM;
        u.pm = fm + ((wgid % nig) % gsz); u.pn = (wgid % nig) / gsz; return true;
    }
    __device__ __forceinline__ void a_ready(const Unit&) const {}
    __device__ __forceinline__ void done(const Unit&) const {}
};

__device__ __forceinline__ unsigned cvt_pk_bf16(float lo, float hi) { unsigned r; asm volatile("v_cvt_pk_bf16_f32 %0, %1, %2" : "=v"(r) : "v"(lo), "v"(hi)); return r; }
typedef float f32x2 __attribute__((ext_vector_type(2)));
__device__ __forceinline__ f32x2 gelu_pk(f32x2 v) {
    const f32x2 av = __builtin_elementwise_abs(v), d = av * 0.2316418882f + 1.0f;
    f32x2 t; t.x = __builtin_amdgcn_rcpf(d.x); t.y = __builtin_amdgcn_rcpf(d.y);
    f32x2 q = t * 0.5307027145f + (-0.7265760135f); q = q * t + 0.7107068705f; q = q * t + (-0.142248368f); q = q * t + 0.127414796f; q = q * t;
    const f32x2 s = (v * v) * (-0.72134752044f);
    f32x2 e; e.x = __builtin_amdgcn_exp2f(s.x); e.y = __builtin_amdgcn_exp2f(s.y);
    const f32x2 m = v * (q * e), r = v - m;
    f32x2 o; o.x = v.x < 0.f ? m.x : r.x; o.y = v.y < 0.f ? m.y : r.y; return o;
}

template <int ACT  > struct EpiBf16 {
    static constexpr bool PERM = true, AFTER_DRAIN = false; static_assert(ACT == 0 || ACT == 1, "EpiBf16: ACT is 0 (none) or 1 (gelu_pk)");
    bf16_t* O; int ldc; const float* bias; int split_cols; size_t split_stride; float scale0;
    __device__ __forceinline__ void operator()(const f32x4 (&acc)[2][2][4][2], const Unit& u, int wr, int wc, int fr, int fq) const {
        const int row0 = u.pm * BM + wr * 64 + fr; int colt = u.pn * BM; bf16_t* base = O;
        float sc = 1.f; if (split_cols) { const int t = colt / split_cols; base += (size_t)t * split_stride; colt -= t * split_cols; if (t == 0) sc = scale0; }
        const int col0 = colt + wc * 32 + 8 * fq, bcol0 = u.pn * BM + wc * 32 + 8 * fq;
        f32x4 bv[2][2];
#pragma unroll
        for (int bj = 0; bj < 2; ++bj)
#pragma unroll
            for (int n = 0; n < 2; ++n) bv[bj][n] = bias ? *(const f32x4*)(bias + bcol0 + bj * HALF + 4 * n) : (f32x4){0.f, 0.f, 0.f, 0.f};
#pragma unroll
        for (int ai = 0; ai < 2; ++ai)
#pragma unroll
            for (int m = 0; m < 4; ++m) { bf16_t* rowp = base + (size_t)(row0 + ai * HALF + m * 16) * ldc + col0;
#pragma unroll
                for (int bj = 0; bj < 2; ++bj) { f32x4 v0 = acc[ai][bj][m][0] + bv[bj][0], v1 = acc[ai][bj][m][1] + bv[bj][1];
                    if (ACT == 1) { f32x2 a = gelu_pk((f32x2){v0[0], v0[1]}), b = gelu_pk((f32x2){v0[2], v0[3]}), c = gelu_pk((f32x2){v1[0], v1[1]}), d = gelu_pk((f32x2){v1[2], v1[3]});
                        v0 = (f32x4){a.x, a.y, b.x, b.y}; v1 = (f32x4){c.x, c.y, d.x, d.y}; }
                    v0 = v0 * sc; v1 = v1 * sc; u32x4 w; w.x = cvt_pk_bf16(v0[0], v0[1]); w.y = cvt_pk_bf16(v0[2], v0[3]); w.z = cvt_pk_bf16(v1[0], v1[1]); w.w = cvt_pk_bf16(v1[2], v1[3]);
                    *(u32x4*)(rowp + bj * HALF) = w; } }
    }
};

struct EpiF32 {
    static constexpr bool PERM = true, AFTER_DRAIN = false;
    float* O; int ldc;
    __device__ __forceinline__ void operator()(const f32x4 (&acc)[2][2][4][2], const Unit& u, int wr, int wc, int fr, int fq) const {
        const int row0 = u.pm * BM + wr * 64 + fr, col0 = u.pn * BM + wc * 32 + 8 * fq;
#pragma unroll
        for (int ai = 0; ai < 2; ++ai)
#pragma unroll
            for (int m = 0; m < 4; ++m) { float* rowp = O + (size_t)(row0 + ai * HALF + m * 16) * ldc + col0;
#pragma unroll
                for (int bj = 0; bj < 2; ++bj) { *(f32x4*)(rowp + bj * HALF) = acc[ai][bj][m][0]; *(f32x4*)(rowp + bj * HALF + 4) = acc[ai][bj][m][1]; } }
    }
};
template <class Epi, class Sched, bool ALIGN_EPI = false, bool SP2 = false>
__device__ __forceinline__ void gemm_phase(PG8_LAS unsigned char* lds, const Gemm g, const Sched& S, const Epi& E) {
    const int tid = threadIdx.x, wid = __builtin_amdgcn_readfirstlane(tid >> 6), lane = tid & 63, wr = wid >> 2, wc = wid & 3, fr = lane & 15, fq = lane >> 4;
    const int K = g.K, nt = K / BK;
    unsigned voffA[2], voffB[2];
#pragma unroll
    for (int i = 0; i < 2; ++i) { int R, C; stage_rc(tid * 16 + i * 8192, R, C); const int Rb = Epi::PERM ? ((R & ~31) + perm32(R & 31)) : R;
        voffA[i] = (unsigned)(R * K + C) * 2u; voffB[i] = (unsigned)(Rb * K + C) * 2u; }
    const size_t kstep = (size_t)(BK * 2);
    const size_t hstep = (size_t)HALF * K * 2;
    const size_t tstep = 2 * hstep;
    const unsigned ldsw = (unsigned)wid * 1024u;
    const int aoff = lds_byte(wr * 64 + fr, fq * 8), boff = lds_byte(wc * 32 + fr, fq * 8);
#define PG8_SA(b, h) (((b) * 2 + (h)) * HTB)
#define PG8_SB(b, h) ((4 + (b) * 2 + (h)) * HTB)
#define PG8_STAGE(bufoff, gbase, voff) do { _Pragma("unroll") for (int _i = 0; _i < 2; ++_i) \
        __builtin_amdgcn_global_load_lds((const unsigned*)((const char*)(gbase) + (voff)[_i]), (PG8_LAS unsigned*)(lds + (bufoff) + ldsw + _i * 8192), 16, 0, 0); } while (0)
#define PG8_LDA(dst, b, h) do { _Pragma("unroll") for (int m = 0; m < 4; ++m) _Pragma("unroll") for (int k = 0; k < 2; ++k) dst[m][k] = *(const PG8_LAS bf16x8*)(lds + PG8_SA(b, h) + aoff + m * 2048 + k * 1024); } while (0)
#define PG8_LDB(dst, b, h) do { _Pragma("unroll") for (int n = 0; n < 2; ++n) _Pragma("unroll") for (int k = 0; k < 2; ++k) dst[n][k] = *(const PG8_LAS bf16x8*)(lds + PG8_SB(b, h) + boff + n * 2048 + k * 1024); } while (0)
#define PG8_MMA(ai, bj, At, Bt) do { __builtin_amdgcn_s_setprio(1); _Pragma("unroll") for (int m = 0; m < 4; ++m) _Pragma("unroll") for (int n = 0; n < 2; ++n) _Pragma("unroll") for (int k = 0; k < 2; ++k) \
        acc[ai][bj][m][n] = __builtin_amdgcn_mfma_f32_16x16x32_bf16(Bt[n][k], At[m][k], acc[ai][bj][m][n], 0, 0, 0); __builtin_amdgcn_s_setprio(0); } while (0)
#define PG8_WAIT_V(n) asm volatile("s_waitcnt vmcnt(" #n ")" ::: "memory")
#define PG8_WAIT_L(n) asm volatile("s_waitcnt lgkmcnt(" #n ")" ::: "memory")
#define PG8_BAR __builtin_amdgcn_s_barrier()
#define PG8_SCHED __builtin_amdgcn_sched_barrier(0)
    Unit cur, nxt; int ui = 0;
    if (!S.next(0, cur)) return;
    f32x4 acc[2][2][4][2];
#pragma unroll
    for (int a = 0; a < 2; ++a)
#pragma unroll
        for (int b = 0; b < 2; ++b)
#pragma unroll
            for (int m = 0; m < 4; ++m)
#pragma unroll
                for (int n = 0; n < 2; ++n) acc[a][b][m][n] = (f32x4){0.f, 0.f, 0.f, 0.f};
    bf16x8 At[4][2], B0[2][2], B1[2][2];
    const char* cA = (const char*)g.A + (size_t)cur.pm * tstep; const char* cB = (const char*)g.Bt + (size_t)cur.pn * tstep;
    S.a_ready(cur);
    if constexpr (SP2) {
        PG8_STAGE(PG8_SB(0, 0), cB, voffB); PG8_STAGE(PG8_SB(0, 1), cB + hstep, voffB); PG8_STAGE(PG8_SA(0, 0), cA, voffA); PG8_STAGE(PG8_SA(0, 1), cA + hstep, voffA);
        if (wr == 1) PG8_BAR;
        PG8_WAIT_V(2); PG8_BAR;
        PG8_STAGE(PG8_SB(1, 0), cB + kstep, voffB); PG8_STAGE(PG8_SA(1, 0), cA + kstep, voffA); PG8_STAGE(PG8_SB(1, 1), cB + hstep + kstep, voffB);
        PG8_WAIT_V(6); PG8_BAR;
    } else {
        PG8_STAGE(PG8_SB(0, 0), cB, voffB); PG8_STAGE(PG8_SA(0, 0), cA, voffA); PG8_STAGE(PG8_SB(0, 1), cB + hstep, voffB); PG8_STAGE(PG8_SA(0, 1), cA + hstep, voffA);
        if (wr == 1) PG8_BAR;
        PG8_WAIT_V(4); PG8_BAR;
        PG8_STAGE(PG8_SB(1, 0), cB + kstep, voffB); PG8_STAGE(PG8_SA(1, 0), cA + kstep, voffA); PG8_STAGE(PG8_SB(1, 1), cB + hstep + kstep, voffB);
        PG8_WAIT_V(6); PG8_BAR;
    }
    for (;;) {
        const bool has_next = S.next(ui + 1, nxt);
        const char* nA = has_next ? (const char*)g.A + (size_t)nxt.pm * tstep : cA; const char* nB = has_next ? (const char*)g.Bt + (size_t)nxt.pn * tstep : cB;
        for (int t = 0; t < nt; t += 2) {
            const bool last = (t == nt - 2);
            const char* a1 = cA + (size_t)(t + 1) * kstep;
            const char* a2 = last ? nA : cA + (size_t)(t + 2) * kstep; const char* b2 = last ? nB : cB + (size_t)(t + 2) * kstep;
            const char* a3 = a2 + kstep; const char* b3 = b2 + kstep;
            if (last && has_next) S.a_ready(nxt);
            if constexpr (SP2) {
            PG8_LDB(B0, 0, 0); PG8_LDB(B1, 0, 1); PG8_SCHED; PG8_LDA(At, 0, 0); PG8_STAGE(PG8_SA(1, 1), a1 + hstep, voffA);
            PG8_WAIT_V(8); PG8_WAIT_L(0); PG8_BAR; PG8_MMA(0, 0, At, B0); PG8_MMA(0, 1, At, B1); PG8_BAR; PG8_SCHED;
            PG8_LDA(At, 0, 1); PG8_STAGE(PG8_SB(0, 0), b2, voffB); PG8_STAGE(PG8_SB(0, 1), b2 + hstep, voffB); PG8_STAGE(PG8_SA(0, 0), a2, voffA);
            PG8_WAIT_V(8); PG8_WAIT_L(0); PG8_BAR; PG8_MMA(1, 0, At, B0); PG8_MMA(1, 1, At, B1); PG8_BAR; PG8_SCHED;
            PG8_LDB(B0, 1, 0); PG8_LDB(B1, 1, 1); PG8_SCHED; PG8_LDA(At, 1, 0); PG8_STAGE(PG8_SA(0, 1), a2 + hstep, voffA);
            PG8_WAIT_V(8); PG8_WAIT_L(0); PG8_BAR; PG8_MMA(0, 0, At, B0); PG8_MMA(0, 1, At, B1); PG8_BAR; PG8_SCHED;
            PG8_LDA(At, 1, 1); PG8_STAGE(PG8_SB(1, 0), b3, voffB); PG8_STAGE(PG8_SB(1, 1), b3 + hstep, voffB); PG8_STAGE(PG8_SA(1, 0), a3, voffA);
            PG8_WAIT_V(8); PG8_WAIT_L(0); PG8_BAR; PG8_MMA(1, 0, At, B0); PG8_MMA(1, 1, At, B1); PG8_BAR; PG8_SCHED;
            } else {
            PG8_LDB(B0, 0, 0); PG8_SCHED; PG8_LDA(At, 0, 0); PG8_STAGE(PG8_SA(1, 1), a1 + hstep, voffA);
            PG8_WAIT_L(8); PG8_BAR; PG8_WAIT_L(0); PG8_MMA(0, 0, At, B0); PG8_BAR; PG8_SCHED;
            PG8_LDB(B1, 0, 1); PG8_STAGE(PG8_SB(0, 0), b2, voffB);
            PG8_BAR; PG8_WAIT_L(0); PG8_MMA(0, 1, At, B1); PG8_BAR;
            PG8_LDA(At, 0, 1); PG8_STAGE(PG8_SA(0, 0), a2, voffA);
            PG8_BAR; PG8_WAIT_L(0); PG8_MMA(1, 0, At, B0); PG8_BAR; PG8_SCHED;
            PG8_STAGE(PG8_SB(0, 1), b2 + hstep, voffB);
            PG8_WAIT_V(6); PG8_BAR; PG8_MMA(1, 1, At, B1); PG8_BAR;
            PG8_LDB(B0, 1, 0); PG8_SCHED; PG8_LDA(At, 1, 0); PG8_STAGE(PG8_SA(0, 1), a2 + hstep, voffA);
            PG8_WAIT_L(8); PG8_BAR; PG8_WAIT_L(0); PG8_MMA(0, 0, At, B0); PG8_BAR; PG8_SCHED;
            PG8_LDB(B1, 1, 1); PG8_STAGE(PG8_SB(1, 0), b3, voffB);
            PG8_BAR; PG8_WAIT_L(0); PG8_MMA(0, 1, At, B1); PG8_BAR;
            PG8_LDA(At, 1, 1); PG8_STAGE(PG8_SA(1, 0), a3, voffA);
            PG8_BAR; PG8_WAIT_L(0); PG8_MMA(1, 0, At, B0); PG8_BAR; PG8_SCHED;
            PG8_STAGE(PG8_SB(1, 1), b3 + hstep, voffB);
            PG8_WAIT_V(6); PG8_BAR; PG8_MMA(1, 1, At, B1); PG8_BAR;
            }
        }
        if constexpr (ALIGN_EPI) { if (wr == 0) PG8_BAR; }
        if constexpr (!Epi::AFTER_DRAIN) { E(acc, cur, wr, wc, fr, fq); S.done(cur); }
        if (!has_next) break;
#pragma unroll
        for (int a = 0; a < 2; ++a)
#pragma unroll
            for (int b = 0; b < 2; ++b)
#pragma unroll
                for (int m = 0; m < 4; ++m)
#pragma unroll
                    for (int n = 0; n < 2; ++n) acc[a][b][m][n] = (f32x4){0.f, 0.f, 0.f, 0.f};
        cur = nxt; cA = nA; cB = nB; ++ui;
        if constexpr (ALIGN_EPI) { if (wr == 1) PG8_BAR; }
    }
    PG8_WAIT_V(0);
    if constexpr (!ALIGN_EPI) { if (wr == 0) PG8_BAR; }
    PG8_BAR;
    if constexpr (Epi::AFTER_DRAIN) { E.fused(acc, cur, wr, wc, fr, fq, lds, wid, lane); S.done(cur); }
#undef PG8_SA
#undef PG8_SB
#undef PG8_STAGE
#undef PG8_LDA
#undef PG8_LDB
#undef PG8_MMA
#undef PG8_WAIT_V
#undef PG8_WAIT_L
#undef PG8_BAR
#undef PG8_SCHED
}
}

struct Frame {
    unsigned char* lds;
    int tid, lane, wave, vcu, G;
    const float *x, *w_in, *w_gate, *b_gate, *gla_g, *sb_g, *w_out, *ln1_g, *ln1_b, *w_q, *sub_keys, *pu, *pv, *ln2_g, *ln2_b;
    float* out;
    unsigned char* ws;
};
#define WSP(type, off) ((type*)(F.ws + (off)))

__device__ __forceinline__ void p0_transpose_item(const float* W, int K, int ldw, int c0, int ncols, bf16* WT, int row_off, float* scr, int item, int lane) {
    const int nblk = ncols / 32, kb = item / nblk, nb = item % nblk, k0 = 64 * kb, n0 = 32 * nb;
#pragma unroll 8
    for (int i = 0; i < 32; ++i) { const int kk = 2 * i + (lane >> 5); scr[kk * 33 + (lane & 31)] = W[(size_t)(k0 + kk) * ldw + c0 + n0 + (lane & 31)]; }
    asm volatile("s_waitcnt lgkmcnt(0)" ::: "memory");
    const int c = lane & 7;
#pragma unroll
    for (int j = 0; j < 4; ++j) { const int n = (lane >> 3) + 8 * j; const float* s = scr + (8 * c) * 33 + n;
        v4u o; o.x = pk2(s[0 * 33], s[1 * 33]); o.y = pk2(s[2 * 33], s[3 * 33]); o.z = pk2(s[4 * 33], s[5 * 33]); o.w = pk2(s[6 * 33], s[7 * 33]);
        *(v4u*)(WT + (size_t)(row_off + n0 + n) * K + k0 + 8 * c) = o; }
    asm volatile("s_waitcnt lgkmcnt(0)" ::: "memory");
}
__device__ __forceinline__ void cvt_f32_bf16_bulk(Frame& F, const float* src, bf16* dst, size_t n8) {
    const size_t gt = (size_t)F.vcu * NTHR + F.tid, NT = (size_t)F.G * NTHR;
    for (size_t i = gt; i < n8; i += NT) {
        const f32x4 a = *(const f32x4*)(src + i * 8), b = *(const f32x4*)(src + i * 8 + 4);
        v4u o; o.x = pk2(a.x, a.y); o.y = pk2(a.z, a.w); o.z = pk2(b.x, b.y); o.w = pk2(b.z, b.w);
        *(v4u*)(dst + i * 8) = o;
    }
}
__device__ __forceinline__ void ph0_prologue(Frame& F) {
    float* wa = (float*)F.lds;
    float* scr = (float*)(F.lds + 65536 + F.wave * 8448);
    const int gw = F.vcu * NWAVES + F.wave, NGW = F.G * NWAVES;
    for (int idx = F.tid; idx < 16384; idx += NTHR) { const int k = idx >> 4, r = idx & 15; wa[r * 1024 + k] = F.w_in[(size_t)k * INW + A_COL + r]; }
#ifndef P0_REP
#define P0_REP -1
#endif
#define P0R(n) for (int rp_ = 0; rp_ < ((P0_REP == (n)) ? 3 : 1); ++rp_)
    constexpr int I_IN1 = 16 * 48, I_IN2 = 16 * 48, I_OUT = 16 * 32, I_Q = 16 * 64, NITEMS = I_IN1 + I_IN2 + I_OUT + I_Q;
    P0R(0) for (int it = gw; it < NITEMS; it += NGW) {
        int r = it;
        if (r < I_IN1) { p0_transpose_item(F.w_in, 1024, INW, 0, 1536, WSP(bf16, WS_WTIN), 0, scr, r, F.lane); continue; } r -= I_IN1;
        if (r < I_IN2) { p0_transpose_item(F.w_in, 1024, INW, 1552, 1536, WSP(bf16, WS_WTIN), 1536, scr, r, F.lane); continue; } r -= I_IN2;
        if (r < I_OUT) { p0_transpose_item(F.w_out, 1024, 1024, 0, 1024, WSP(bf16, WS_WTOUT), 0, scr, r, F.lane); continue; } r -= I_OUT;
        p0_transpose_item(F.w_q, 1024, 2048, 0, 2048, WSP(bf16, WS_WTQ), 0, scr, r, F.lane);
    }
    P0R(1) cvt_f32_bf16_bulk(F, F.sub_keys, WSP(bf16, WS_SKB), (size_t)8 * 2 * 128 * 128 / 8);
    P0R(2) for (int it = gw; it < 2 * 16384; it += NGW) {
        const int tb = it >> 14, e = it & 16383; const float* src = (tb ? F.pv : F.pu) + (size_t)e * DM + 16 * F.lane;
        f32x4 a[4]; float mx = 0.f;
#pragma unroll
        for (int j = 0; j < 4; ++j) { a[j] = *(const f32x4*)(src + 4 * j); mx = fmaxf(mx, fmaxf(fmaxf(fabsf(a[j].x), fabsf(a[j].y)), fmaxf(fabsf(a[j].z), fabsf(a[j].w)))); }
#pragma unroll
        for (int o = 1; o < 64; o <<= 1) mx = fmaxf(mx, __shfl_xor(mx, o));
        const float sc = (mx > 0.f) ? 384.0f / mx : 1.0f;
        v4u q;
#pragma unroll
        for (int j = 0; j < 4; ++j) { int w = __builtin_amdgcn_cvt_pk_fp8_f32(a[j].x * sc, a[j].y * sc, 0, false); w = __builtin_amdgcn_cvt_pk_fp8_f32(a[j].z * sc, a[j].w * sc, w, true); q[j] = (unsigned)w; }
        *(v4u*)(F.ws + (tb ? WS_V8 : WS_U8) + (size_t)e * DM + 16 * F.lane) = q;
        if (F.lane == 0) WSP(float, tb ? WS_RSV : WS_RSU)[e] = 1.0f / sc;
    }
    __syncthreads();
    bf16* xb = WSP(bf16, WS_XB); float* alpha = WSP(float, WS_ALPHA);
    float wgr[16][4], bgr[4];
#pragma unroll
    for (int i = 0; i < 4; ++i) { bgr[i] = F.b_gate[F.lane + 64 * i];
#pragma unroll
        for (int r = 0; r < 16; ++r) wgr[r][i] = F.w_gate[r * 256 + F.lane + 64 * i]; }
    P0R(3) for (int m = gw; m < T; m += NGW) {
        const float* xr = F.x + (size_t)m * DM;
        f32x4 xv[4];
#pragma unroll
        for (int i = 0; i < 4; ++i) { xv[i] = *(const f32x4*)(xr + 256 * i + 4 * F.lane);
            v2u o; o.x = pk2(xv[i].x, xv[i].y); o.y = pk2(xv[i].z, xv[i].w); *(v2u*)(xb + (size_t)m * DM + 256 * i + 4 * F.lane) = o; }
        float sg[4] = {bgr[0], bgr[1], bgr[2], bgr[3]};
#pragma unroll
        for (int r = 0; r < 16; ++r) {
            float a = 0.f;
#pragma unroll
            for (int i = 0; i < 4; ++i) { const f32x4 w = *(const f32x4*)(wa + r * 1024 + 256 * i + 4 * F.lane); a += xv[i].x * w.x + xv[i].y * w.y + xv[i].z * w.z + xv[i].w * w.w; }
            a = wave_sum(a);
#pragma unroll
            for (int i = 0; i < 4; ++i) sg[i] += a * wgr[r][i];
            asm volatile("" ::: "memory");
        }
#pragma unroll
        for (int i = 0; i < 4; ++i) { const float la = -(fmaxf(-sg[i], 0.f) + log1pf(expf(-fabsf(sg[i])))) * (1.0f / 16.0f);
            alpha[(size_t)m * 256 + F.lane + 64 * i] = la * 1.4426950408889634f; }
    }
}

struct EpiBf16Store { bf16* C; int ldc;
    __device__ __forceinline__ void operator()(int row, int col, const float (&acc)[8][4]) const {
#pragma unroll
        for (int i = 0; i < 8; ++i) { v2u o; o.x = pk2(acc[i][0], acc[i][1]); o.y = pk2(acc[i][2], acc[i][3]); *(v2u*)(C + (size_t)(row + i) * ldc + col) = o; } } };
struct EpiF32Store { float* C; int ldc;
    __device__ __forceinline__ void operator()(int row, int col, const float (&acc)[8][4]) const {
#pragma unroll
        for (int i = 0; i < 8; ++i) *(f32x4*)(C + (size_t)(row + i) * ldc + col) = (f32x4){acc[i][0], acc[i][1], acc[i][2], acc[i][3]}; } };
template <class Epi>
__device__ __forceinline__ void naive_gemm(Frame& F, const bf16* A, const bf16* Bt, int M, int N, int K, const Epi& epi) {
    float* As = (float*)F.lds; float* Bs = As + 32 * 132;
    const int tid = F.tid, tm = tid >> 5, tn = tid & 31, lr = tid >> 2, lk = (tid & 3) * 8;
    const int nN = N / 128, nU = (M / 128) * nN;
    for (int u = F.vcu; u < nU; u += F.G) {
        const int pm = u / nN, pn = u % nN;
        float acc[8][4];
#pragma unroll
        for (int i = 0; i < 8; ++i)
#pragma unroll
            for (int j = 0; j < 4; ++j) acc[i][j] = 0.f;
        const bf16* ap = A + (size_t)(pm * 128 + lr) * K + lk; const bf16* bp = Bt + (size_t)(pn * 128 + lr) * K + lk;
        for (int k0 = 0; k0 < K; k0 += 32) {
            const v4u av = *(const v4u*)(ap + k0), bv = *(const v4u*)(bp + k0);
            __syncthreads();
#pragma unroll
            for (int j = 0; j < 4; ++j) {
                As[(lk + 2 * j) * 132 + lr] = __uint_as_float(av[j] << 16); As[(lk + 2 * j + 1) * 132 + lr] = __uint_as_float(av[j] & 0xffff0000u);
                Bs[(lk + 2 * j) * 132 + lr] = __uint_as_float(bv[j] << 16); Bs[(lk + 2 * j + 1) * 132 + lr] = __uint_as_float(bv[j] & 0xffff0000u); }
            __syncthreads();
#pragma unroll 4
            for (int k = 0; k < 32; ++k) {
                const f32x4 a0 = *(const f32x4*)(As + k * 132 + tm * 8), a1 = *(const f32x4*)(As + k * 132 + tm * 8 + 4), b = *(const f32x4*)(Bs + k * 132 + tn * 4);
                const float a[8] = {a0.x, a0.y, a0.z, a0.w, a1.x, a1.y, a1.z, a1.w}; const float bb[4] = {b.x, b.y, b.z, b.w};
#pragma unroll
                for (int i = 0; i < 8; ++i)
#pragma unroll
                    for (int j = 0; j < 4; ++j) acc[i][j] += a[i] * bb[j];
            }
        }
        epi(pm * 128 + tm * 8, pn * 128 + tn * 4, acc);
    }
    __syncthreads();
}

constexpr int GROW = 144;
template <bool OUT>
__device__ __forceinline__ void gla_mfma_pass(Frame& F) {
    const bf16* proj = WSP(bf16, WS_PROJ); const float* LA = WSP(float, WS_ALPHA); bf16* cat = WSP(bf16, WS_CAT);
    float* deltaT = WSP(float, WS_SLOC); float* dec = WSP(float, WS_DEC); const bf16* SBF = WSP(bf16, WS_SBF);
    unsigned char* L = F.lds;
    float* B2 = (float*)L;
    unsigned char* QI = L + 16384;
    unsigned char* KI = L + 25600;
    unsigned char* VT = L + 34816;
    float* SS = (float*)(L + 53248);
    const int tid = F.tid, lane = F.lane, w = F.wave, c32 = lane & 31, hf = lane >> 5;
    const int tt = tid >> 3, c8 = (tid & 7) * 8, e16 = (tid & 7) * 16;
    for (int u = F.vcu; u < 1024; u += F.G) {
        const int bh = u >> 7, ch = u & 127, b = bh >> 2, h = bh & 3; const size_t row0 = (size_t)b * SEQ + ch * 64; const size_t row = row0 + tt;
        const f32x4 l0 = *(const f32x4*)(LA + row * 256 + h * 64 + c8), l1 = *(const f32x4*)(LA + row * 256 + h * 64 + c8 + 4);
        const v4u kk = *(const v4u*)(proj + row * NPJ + C_KG + h * 64 + c8);
        v4u qq = (v4u){0u, 0u, 0u, 0u}; if (OUT) qq = *(const v4u*)(proj + row * NPJ + C_QG + h * 64 + c8);
        const v4u v0 = *(const v4u*)(proj + row * NPJ + C_VG + h * 128 + e16), v1 = *(const v4u*)(proj + row * NPJ + C_VG + h * 128 + e16 + 8);
        __syncthreads();
        *(f32x4*)(B2 + tt * 64 + c8) = l0; *(f32x4*)(B2 + tt * 64 + c8 + 4) = l1;
#pragma unroll
        for (int i = 0; i < 4; ++i) {
            *(unsigned short*)(VT + (e16 + 2 * i) * GROW + tt * 2) = (unsigned short)(v0[i] & 0xffffu); *(unsigned short*)(VT + (e16 + 2 * i + 1) * GROW + tt * 2) = (unsigned short)(v0[i] >> 16);
            *(unsigned short*)(VT + (e16 + 8 + 2 * i) * GROW + tt * 2) = (unsigned short)(v1[i] & 0xffffu); *(unsigned short*)(VT + (e16 + 8 + 2 * i + 1) * GROW + tt * 2) = (unsigned short)(v1[i] >> 16); }
        __syncthreads();
        if (tid < 256) { const int c = tid & 63, q4 = tid >> 6; float a = 0.f;
#pragma unroll
            for (int i = 0; i < 16; ++i) { a += B2[(16 * q4 + i) * 64 + c]; B2[(16 * q4 + i) * 64 + c] = a; } }
        __syncthreads();
        float bv[8], bl[8];
        { const f32x4 x0 = *(const f32x4*)(B2 + tt * 64 + c8), x1 = *(const f32x4*)(B2 + tt * 64 + c8 + 4);
          bv[0] = x0.x; bv[1] = x0.y; bv[2] = x0.z; bv[3] = x0.w; bv[4] = x1.x; bv[5] = x1.y; bv[6] = x1.z; bv[7] = x1.w;
#pragma unroll
          for (int i = 0; i < 8; ++i) bl[i] = 0.f;
#pragma unroll
          for (int q = 0; q < 4; ++q) { const f32x4 t0 = *(const f32x4*)(B2 + (16 * q + 15) * 64 + c8), t1 = *(const f32x4*)(B2 + (16 * q + 15) * 64 + c8 + 4);
              const float tq[8] = {t0.x, t0.y, t0.z, t0.w, t1.x, t1.y, t1.z, t1.w}; const bool before = q < (tt >> 4);
#pragma unroll
              for (int i = 0; i < 8; ++i) { bl[i] += tq[i]; bv[i] += before ? tq[i] : 0.f; } } }
        float kf[8];
#pragma unroll
        for (int i = 0; i < 4; ++i) { kf[2 * i] = __uint_as_float(kk[i] << 16); kf[2 * i + 1] = __uint_as_float(kk[i] & 0xffff0000u); }
        if (!OUT) {
#pragma unroll
            for (int i = 0; i < 8; ++i) { const float ksv = kf[i] * __builtin_amdgcn_exp2f(bl[i] - bv[i]);
                *(unsigned short*)(QI + (c8 + i) * GROW + tt * 2) = (unsigned short)f2bf(ksv); }
            if (tt == 63) {
#pragma unroll
                for (int i = 0; i < 8; ++i) dec[(size_t)u * 64 + c8 + i] = __builtin_amdgcn_exp2f(bl[i]); }
        } else {
            v4u qo, ko;
#pragma unroll
            for (int i = 0; i < 4; ++i) {
                const float q0 = __uint_as_float(qq[i] << 16) * 0.125f * __builtin_amdgcn_exp2f(bv[2 * i]), q1 = __uint_as_float(qq[i] & 0xffff0000u) * 0.125f * __builtin_amdgcn_exp2f(bv[2 * i + 1]);
                const float k0 = kf[2 * i] * __builtin_amdgcn_exp2f(-bv[2 * i]), k1 = kf[2 * i + 1] * __builtin_amdgcn_exp2f(-bv[2 * i + 1]);
                qo[i] = pk2(q0, q1); ko[i] = pk2(k0, k1); }
            *(v4u*)(QI + tt * GROW + c8 * 2) = qo; *(v4u*)(KI + tt * GROW + c8 * 2) = ko;
        }
        __syncthreads();
        if (!OUT) {
            const int eb = w >> 1, cb = w & 1;
            f32x16 acc;
#pragma unroll
            for (int r = 0; r < 16; ++r) acc[r] = 0.f;
#pragma unroll
            for (int s4 = 0; s4 < 4; ++s4) { const bf16x8 af = *(const bf16x8*)(VT + (eb * 32 + c32) * GROW + (16 * s4 + 8 * hf) * 2), bfr = *(const bf16x8*)(QI + (cb * 32 + c32) * GROW + (16 * s4 + 8 * hf) * 2);
                acc = __builtin_amdgcn_mfma_f32_32x32x16_bf16(af, bfr, acc, 0, 0, 0); }
#pragma unroll
            for (int r = 0; r < 16; ++r) { const int e = eb * 32 + (r & 3) + 8 * (r >> 2) + 4 * hf; deltaT[(size_t)u * 8192 + e * 64 + cb * 32 + c32] = acc[r]; }
        } else {
            const int tb = w & 1, eb = w >> 1, t = tb * 32 + c32;
            v2u gg[4];
#pragma unroll
            for (int g4 = 0; g4 < 4; ++g4) gg[g4] = *(const v2u*)(proj + (row0 + t) * NPJ + C_GG + h * 128 + eb * 32 + 8 * g4 + 4 * hf);
            bf16x8 QF[4], SF[4];
#pragma unroll
            for (int s4 = 0; s4 < 4; ++s4) { QF[s4] = *(const bf16x8*)(QI + t * GROW + (16 * s4 + 8 * hf) * 2); SF[s4] = *(const bf16x8*)(SBF + (size_t)u * 8192 + (eb * 32 + c32) * 64 + 16 * s4 + 8 * hf); }
            f32x16 o;
#pragma unroll
            for (int r = 0; r < 16; ++r) o[r] = 0.f;
#pragma unroll
            for (int jb = 0; jb < 2; ++jb) if (jb <= tb) {
                f32x16 at;
#pragma unroll
                for (int r = 0; r < 16; ++r) at[r] = 0.f;
#pragma unroll
                for (int s4 = 0; s4 < 4; ++s4) { const bf16x8 KF = *(const bf16x8*)(KI + (jb * 32 + c32) * GROW + (16 * s4 + 8 * hf) * 2); at = __builtin_amdgcn_mfma_f32_32x32x16_bf16(KF, QF[s4], at, 0, 0, 0); }
                if (jb == tb) {
#pragma unroll
                    for (int r = 0; r < 16; ++r) { const int jl = (r & 3) + 8 * (r >> 2) + 4 * hf; at[r] = (jl <= c32) ? at[r] : 0.f; } }
                v4u pw[2];
#pragma unroll
                for (int r = 0; r < 16; r += 2) pw[r >> 3][(r & 7) >> 1] = pk2(at[r], at[r + 1]);
#pragma unroll
                for (int ks = 0; ks < 2; ++ks) { const unsigned char* vp = VT + (eb * 32 + c32) * GROW + (jb * 32 + 16 * ks + 4 * hf) * 2;
                    const v2u lo = *(const v2u*)vp, hi = *(const v2u*)(vp + 16);
                    const v4u vfw = (v4u){lo.x, lo.y, hi.x, hi.y};
                    o = __builtin_amdgcn_mfma_f32_32x32x16_bf16(__builtin_bit_cast(bf16x8, vfw), __builtin_bit_cast(bf16x8, pw[ks]), o, 0, 0, 0); }
            }
#pragma unroll
            for (int s4 = 0; s4 < 4; ++s4) o = __builtin_amdgcn_mfma_f32_32x32x16_bf16(SF[s4], QF[s4], o, 0, 0, 0);
            float ss = 0.f;
#pragma unroll
            for (int r = 0; r < 16; ++r) ss += o[r] * o[r];
            ss += __shfl_xor(ss, 32);
            if (hf == 0) SS[eb * 64 + t] = ss;
            __syncthreads();
            const float tot = (SS[t] + SS[64 + t]) + (SS[128 + t] + SS[192 + t]);
            const float rn = rsqrtf(tot * (1.0f / 128.0f) + EPS);
#pragma unroll
            for (int g4 = 0; g4 < 4; ++g4) { const int e0 = eb * 32 + 8 * g4 + 4 * hf; const f32x4 gn = *(const f32x4*)(F.gla_g + h * 128 + e0);
                const float ga = __uint_as_float(gg[g4].x << 16), gb = __uint_as_float(gg[g4].x & 0xffff0000u), gc = __uint_as_float(gg[g4].y << 16), gd = __uint_as_float(gg[g4].y & 0xffff0000u);
                const float y0 = o[4 * g4] * rn * gn.x * (ga / (1.f + __expf(-ga))), y1 = o[4 * g4 + 1] * rn * gn.y * (gb / (1.f + __expf(-gb)));
                const float y2 = o[4 * g4 + 2] * rn * gn.z * (gc / (1.f + __expf(-gc))), y3 = o[4 * g4 + 3] * rn * gn.w * (gd / (1.f + __expf(-gd)));
                v2u yo; yo.x = pk2(y0, y1); yo.y = pk2(y2, y3); *(v2u*)(cat + (row0 + t) * DM + h * 128 + e0) = yo; }
        }
    }
    __syncthreads();
}
__device__ __forceinline__ void gla_scan(Frame& F) {
    const float* deltaT = WSP(float, WS_SLOC); const float* dec = WSP(float, WS_DEC); bf16* SBF = WSP(bf16, WS_SBF);
    const int g = F.vcu * NTHR + F.tid;
    if (g >= 65536) return;
    const int bh = g >> 13, ec = g & 8191, c = ec & 63;
    const float* sp = deltaT + (size_t)bh * 128 * 8192 + ec; const float* dp = dec + (size_t)bh * 128 * 64 + c; bf16* op = SBF + (size_t)bh * 128 * 8192 + ec;
    float S = 0.f; float v[8], d[8];
#pragma unroll
    for (int j = 0; j < 8; ++j) { v[j] = sp[(size_t)j * 8192]; d[j] = dp[j * 64]; }
    for (int s0 = 0; s0 < 128; s0 += 8) {
        float vn[8], dn[8];
        const int s1 = (s0 + 8 < 128) ? s0 + 8 : s0;
#pragma unroll
        for (int j = 0; j < 8; ++j) { vn[j] = sp[(size_t)(s1 + j) * 8192]; dn[j] = dp[(s1 + j) * 64]; }
#pragma unroll
        for (int j = 0; j < 8; ++j) { op[(size_t)(s0 + j) * 8192] = (bf16)f2bf(S); S = S * d[j] + v[j]; }
#pragma unroll
        for (int j = 0; j < 8; ++j) { v[j] = vn[j]; d[j] = dn[j]; }
    }
}
__device__ __forceinline__ void ph2_sb_naive(Frame& F) {
    const bf16* proj = WSP(bf16, WS_PROJ); bf16* cat = WSP(bf16, WS_CAT);
    float* Ks = (float*)F.lds; float* Vs = Ks + 32 * 64;
    const int tid = F.tid;
    for (int u = F.vcu; u < 256; u += F.G) {
        const int bh = u >> 4, qb = u & 15, b = bh >> 3, h = bh & 7, t = qb * 512 + tid; const size_t row = (size_t)b * SEQ + t;
        float q[64], o[64];
#pragma unroll
        for (int i = 0; i < 8; ++i) { const v4u w = *(const v4u*)(proj + row * NPJ + C_QS + h * 64 + 8 * i);
#pragma unroll
            for (int j = 0; j < 4; ++j) { q[8 * i + 2 * j] = __uint_as_float(w[j] << 16) * 0.125f; q[8 * i + 2 * j + 1] = __uint_as_float(w[j] & 0xffff0000u) * 0.125f; } }
#pragma unroll
        for (int d = 0; d < 64; ++d) o[d] = 0.f;
        float tail = 0.f;
        for (int kt = (qb * 512 + 511) / 32; kt >= 0; --kt) {
            if (__syncthreads_and(tail < -SB_EXIT_NAT)) break;
            { const int key = tid >> 4, d4 = (tid & 15) * 4; const size_t krow = (size_t)b * SEQ + kt * 32 + key;
              const v2u kk = *(const v2u*)(proj + krow * NPJ + C_KS + h * 64 + d4), vv = *(const v2u*)(proj + krow * NPJ + C_VS + h * 64 + d4);
              *(f32x4*)(Ks + key * 64 + d4) = (f32x4){__uint_as_float(kk.x << 16), __uint_as_float(kk.x & 0xffff0000u), __uint_as_float(kk.y << 16), __uint_as_float(kk.y & 0xffff0000u)};
              *(f32x4*)(Vs + key * 64 + d4) = (f32x4){__uint_as_float(vv.x << 16), __uint_as_float(vv.x & 0xffff0000u), __uint_as_float(vv.y << 16), __uint_as_float(vv.y & 0xffff0000u)}; }
            __syncthreads();
            for (int j = 31; j >= 0; --j) {
                const int s = kt * 32 + j;
                float z = 0.f;
#pragma unroll
                for (int d4 = 0; d4 < 16; ++d4) { const f32x4 k4 = *(const f32x4*)(Ks + j * 64 + 4 * d4); z += q[4 * d4] * k4.x + q[4 * d4 + 1] * k4.y + q[4 * d4 + 2] * k4.z + q[4 * d4 + 3] * k4.w; }
                const bool valid = s < t;
                const float lnb = logsig_neg(z);
                const float w = valid ? expf(z + lnb + tail) : 0.f;
                tail += valid ? lnb : 0.f;
#pragma unroll
                for (int d4 = 0; d4 < 16; ++d4) { const f32x4 v4 = *(const f32x4*)(Vs + j * 64 + 4 * d4); o[4 * d4] += w * v4.x; o[4 * d4 + 1] += w * v4.y; o[4 * d4 + 2] += w * v4.z; o[4 * d4 + 3] += w * v4.w; }
            }
        }
        float ss = 0.f;
#pragma unroll
        for (int d = 0; d < 64; ++d) ss += o[d] * o[d];
        const float r = rsqrtf(ss * (1.0f / 64.0f) + EPS);
#pragma unroll
        for (int i = 0; i < 8; ++i) { v4u w;
#pragma unroll
            for (int j = 0; j < 4; ++j) w[j] = pk2(o[8 * i + 2 * j] * r * F.sb_g[h * 64 + 8 * i + 2 * j], o[8 * i + 2 * j + 1] * r * F.sb_g[h * 64 + 8 * i + 2 * j + 1]);
            *(v4u*)(cat + row * DM + 512 + h * 64 + 8 * i) = w; }
    }
    __syncthreads();
}


constexpr float SB_EXIT_L2 = 44.0f;
__device__ __forceinline__ void ph_sb_mfma(Frame& F) {
    const bf16* proj = WSP(bf16, WS_PROJ); bf16* cat = WSP(bf16, WS_CAT);
    const int lane = F.lane, c = lane & 31, hf = lane >> 5;
    const int gw = F.vcu * NWAVES + F.wave, NGW = F.G * NWAVES;
    f16x8 tri[2];
#pragma unroll
    for (int ks = 0; ks < 2; ++ks)
#pragma unroll
        for (int i = 0; i < 8; ++i) { const int j = 16 * ks + 8 * (i >> 2) + 4 * hf + (i & 3); tri[ks][i] = (j >= c) ? (_Float16)1.0f : (_Float16)0.0f; }
    const float CS = 0.125f * 1.4426950408889634f;
    for (int u = gw; u < 4096; u += NGW) {
        const int bh = u >> 8, qb = u & 255, b = bh >> 3, h = bh & 7, q0 = qb * 32;
        const size_t row0 = (size_t)b * SEQ;
        bf16x8 qf[4];
#pragma unroll
        for (int s4 = 0; s4 < 4; ++s4) qf[s4] = *(const bf16x8*)(proj + (row0 + q0 + c) * NPJ + C_QS + h * 64 + 16 * s4 + 8 * hf);
        f32x16 o0, o1;
#pragma unroll
        for (int r = 0; r < 16; ++r) { o0[r] = 0.f; o1[r] = 0.f; }
        float carry = 0.f;
        for (int kt = qb; kt >= 0; --kt) {
            const int kbase = kt * 32;
            const bf16* kp = proj + (row0 + kbase + c) * NPJ + C_KS + h * 64 + 8 * hf;
            bf16x8 kf[4];
#pragma unroll
            for (int s4 = 0; s4 < 4; ++s4) kf[s4] = *(const bf16x8*)(kp + 16 * s4);
            bf16x8 vf[2][2];
#pragma unroll
            for (int db = 0; db < 2; ++db)
#pragma unroll
                for (int ks = 0; ks < 2; ++ks)
#pragma unroll
                    for (int i = 0; i < 8; ++i) { const int key = 16 * ks + 8 * (i >> 2) + 4 * hf + (i & 3);
                        vf[db][ks][i] = (short)proj[(row0 + kbase + key) * NPJ + C_VS + h * 64 + db * 32 + c]; }
            f32x16 z;
#pragma unroll
            for (int r = 0; r < 16; ++r) z[r] = 0.f;
#pragma unroll
            for (int s4 = 0; s4 < 4; ++s4) z = __builtin_amdgcn_mfma_f32_32x32x16_bf16(kf[s4], qf[s4], z, 0, 0, 0);
            const bool diag = (kt == qb);
            f32x16 cin; f16x8 lb[2];
#pragma unroll
            for (int r = 0; r < 16; ++r) {
                const int kl = (r & 3) + 8 * (r >> 2) + 4 * hf;
                const float z2 = z[r] * CS;
                const float l2 = fmaxf(z2, 0.f) + __builtin_amdgcn_logf(1.0f + __builtin_amdgcn_exp2f(-fabsf(z2)));
                const bool valid = !diag || (kl < c);
                lb[r >> 3][r & 7] = (_Float16)(valid ? -l2 : 0.f);
                cin[r] = z2 + carry;
            }
            f32x16 d = __builtin_amdgcn_mfma_f32_32x32x16_f16(tri[0], lb[0], cin, 0, 0, 0);
            d = __builtin_amdgcn_mfma_f32_32x32x16_f16(tri[1], lb[1], d, 0, 0, 0);
            v4u wb[2];
#pragma unroll
            for (int r = 0; r < 16; r += 2) {
                const int kl0 = (r & 3) + 8 * (r >> 2) + 4 * hf;
                const float w0 = (!diag || (kl0 < c)) ? __builtin_amdgcn_exp2f(d[r]) : 0.f;
                const float w1 = (!diag || (kl0 + 1 < c)) ? __builtin_amdgcn_exp2f(d[r + 1]) : 0.f;
                wb[r >> 3][(r & 7) >> 1] = pk2(w0, w1);
            }
            const bf16x8 wf0 = __builtin_bit_cast(bf16x8, wb[0]), wf1 = __builtin_bit_cast(bf16x8, wb[1]);
            o0 = __builtin_amdgcn_mfma_f32_32x32x16_bf16(vf[0][0], wf0, o0, 0, 0, 0);
            o0 = __builtin_amdgcn_mfma_f32_32x32x16_bf16(vf[0][1], wf1, o0, 0, 0, 0);
            o1 = __builtin_amdgcn_mfma_f32_32x32x16_bf16(vf[1][0], wf0, o1, 0, 0, 0);
            o1 = __builtin_amdgcn_mfma_f32_32x32x16_bf16(vf[1][1], wf1, o1, 0, 0, 0);
            float tot = d[0] - cin[0];
            tot = __shfl(tot, c);
            carry += tot;
            if (__all(carry < -SB_EXIT_L2)) break;
        }
        float ss = 0.f;
#pragma unroll
        for (int r = 0; r < 16; ++r) ss += o0[r] * o0[r] + o1[r] * o1[r];
        ss += __shfl_xor(ss, 32);
        const float rn = rsqrtf(ss * (1.0f / 64.0f) + EPS);
        bf16* op = cat + (row0 + q0 + c) * DM + 512 + h * 64 + 4 * hf;
#pragma unroll
        for (int g = 0; g < 4; ++g) {
            const f32x4 g0 = *(const f32x4*)(F.sb_g + h * 64 + 8 * g + 4 * hf), g1 = *(const f32x4*)(F.sb_g + h * 64 + 32 + 8 * g + 4 * hf);
            v2u a, bq;
            a.x = pk2(o0[4 * g] * rn * g0.x, o0[4 * g + 1] * rn * g0.y); a.y = pk2(o0[4 * g + 2] * rn * g0.z, o0[4 * g + 3] * rn * g0.w);
            bq.x = pk2(o1[4 * g] * rn * g1.x, o1[4 * g + 1] * rn * g1.y); bq.y = pk2(o1[4 * g + 2] * rn * g1.z, o1[4 * g + 3] * rn * g1.w);
            *(v2u*)(op + 8 * g) = a; *(v2u*)(op + 32 + 8 * g) = bq;
        }
    }
}
__device__ __forceinline__ void ph4_ln1(Frame& F) {
    const int gw = F.vcu * NWAVES + F.wave, NGW = F.G * NWAVES;
    float* x1 = WSP(float, WS_X1); bf16* x1b = WSP(bf16, WS_X1B);
    for (int m = gw; m < T; m += NGW) {
        f32x4 y[4]; float s = 0.f;
#pragma unroll
        for (int i = 0; i < 4; ++i) { const size_t o = (size_t)m * DM + 256 * i + 4 * F.lane; y[i] = *(const f32x4*)(F.x + o) * ALPHA + *(const f32x4*)(F.out + o); s += (y[i].x + y[i].y) + (y[i].z + y[i].w); }
        const float mean = wave_sum(s) * (1.0f / DM); float q = 0.f;
#pragma unroll
        for (int i = 0; i < 4; ++i) { y[i] = y[i] - mean; q += (y[i].x * y[i].x + y[i].y * y[i].y) + (y[i].z * y[i].z + y[i].w * y[i].w); }
        const float rstd = rsqrtf(wave_sum(q) * (1.0f / DM) + EPS);
#pragma unroll
        for (int i = 0; i < 4; ++i) { const int c = 256 * i + 4 * F.lane; const size_t o = (size_t)m * DM + c;
            const f32x4 r = y[i] * rstd * *(const f32x4*)(F.ln1_g + c) + *(const f32x4*)(F.ln1_b + c);
            *(f32x4*)(x1 + o) = r; v2u w; w.x = pk2(r.x, r.y); w.y = pk2(r.z, r.w); *(v2u*)(x1b + o) = w; }
    }
}

#define TOPK_INSERT(cv, ci, VAL, IDX) do { float _cv = (cv); int _ci = (ci); \
    _Pragma("unroll") for (int _j = 0; _j < 16; ++_j) { const bool _g = _cv > VAL[_j]; const float _tv = VAL[_j]; const int _ti = IDX[_j]; \
        VAL[_j] = _g ? _cv : _tv; IDX[_j] = _g ? _ci : _ti; _cv = _g ? _tv : _cv; _ci = _g ? _ti : _ci; } } while (0)
__device__ __forceinline__ void ph6_topk_naive(Frame& F) {
    const bf16* qry = WSP(bf16, WS_QRY); const bf16* skb = WSP(bf16, WS_SKB);
    int* pidx = WSP(int, WS_PIDX); float* pgate = WSP(float, WS_PGATE);
    float* sk = (float*)F.lds;
    const int tid = F.tid;
    for (int u = F.vcu; u < 256; u += F.G) {
        const int h = u >> 5, tb = u & 31, t = tb * 512 + tid;
        float sv[2][16]; int si[2][16];
#pragma unroll
        for (int p = 0; p < 2; ++p) {
            __syncthreads();
            for (int i = tid; i < 128 * 128 / 2; i += NTHR) { const unsigned w = *(const unsigned*)(skb + (size_t)(h * 2 + p) * 16384 + 2 * i); sk[2 * i] = __uint_as_float(w << 16); sk[2 * i + 1] = __uint_as_float(w & 0xffff0000u); }
            __syncthreads();
            unsigned qp[64];
#pragma unroll
            for (int i = 0; i < 16; ++i) { const v4u w = *(const v4u*)(qry + (size_t)t * 2048 + h * 256 + p * 128 + 8 * i); qp[4 * i] = w.x; qp[4 * i + 1] = w.y; qp[4 * i + 2] = w.z; qp[4 * i + 3] = w.w; }
#pragma unroll
            for (int j = 0; j < 16; ++j) { sv[p][j] = -INFINITY; si[p][j] = 0; }
            for (int n = 0; n < 128; ++n) {
                float s = 0.f;
#pragma unroll
                for (int c4 = 0; c4 < 32; ++c4) { const f32x4 k4 = *(const f32x4*)(sk + n * 128 + 4 * c4);
                    s += __uint_as_float(qp[2 * c4] << 16) * k4.x + __uint_as_float(qp[2 * c4] & 0xffff0000u) * k4.y + __uint_as_float(qp[2 * c4 + 1] << 16) * k4.z + __uint_as_float(qp[2 * c4 + 1] & 0xffff0000u) * k4.w; }
                TOPK_INSERT(s, n, sv[p], si[p]);
            }
        }
        float bv[16]; int bi[16];
#pragma unroll
        for (int j = 0; j < 16; ++j) { bv[j] = -INFINITY; bi[j] = 0; }
#pragma unroll
        for (int i = 0; i < 16; ++i)
#pragma unroll
            for (int j = 0; j < 16; ++j) TOPK_INSERT(sv[0][i] + sv[1][j], si[0][i] * 128 + si[1][j], bv, bi);
        float den = 0.f; float e[16];
#pragma unroll
        for (int j = 0; j < 16; ++j) { e[j] = expf(bv[j] - bv[0]); den += e[j]; }
        const float inv = 1.0f / den;
#pragma unroll
        for (int j4 = 0; j4 < 4; ++j4) {
            *(f32x4*)(pgate + (size_t)t * 128 + h * 16 + 4 * j4) = (f32x4){e[4 * j4] * inv, e[4 * j4 + 1] * inv, e[4 * j4 + 2] * inv, e[4 * j4 + 3] * inv};
            *(v4u*)(pidx + (size_t)t * 128 + h * 16 + 4 * j4) = (v4u){(unsigned)bi[4 * j4], (unsigned)bi[4 * j4 + 1], (unsigned)bi[4 * j4 + 2], (unsigned)bi[4 * j4 + 3]};
        }
    }
    __syncthreads();
}


__device__ __forceinline__ float vmaxf(float a, float b) { float r; asm("v_max_f32 %0, %1, %2" : "=v"(r) : "v"(a), "v"(b)); return r; }
__device__ __forceinline__ float vminf(float a, float b) { float r; asm("v_min_f32 %0, %1, %2" : "=v"(r) : "v"(a), "v"(b)); return r; }
#define PKINS(cv, L) do { float _c = (cv); _Pragma("unroll") for (int _j = 0; _j < 16; ++_j) { const float _h = vmaxf(L[_j], _c); _c = vminf(L[_j], _c); L[_j] = _h; } } while (0)
__device__ __forceinline__ void ph8_topk(Frame& F) {
    const bf16* qry = WSP(bf16, WS_QRY); const bf16* skb = WSP(bf16, WS_SKB);
    int* pidx = WSP(int, WS_PIDX); float* pgate = WSP(float, WS_PGATE);
    const int lane = F.lane, c = lane & 31, hf = lane >> 5; const unsigned hf4 = (unsigned)hf << 2;
    float* wl = (float*)F.lds + F.wave * 1056 + c * 33;
    const int gw = F.vcu * NWAVES + F.wave, NGW = F.G * NWAVES;
    const float NINF = __uint_as_float(0xff800000u);
    for (int u = gw; u < 4096; u += NGW) {
        const int h = u >> 9, t = (u & 511) * 32 + c;
        float LA[16], LB[16];
#pragma unroll
        for (int p = 0; p < 2; ++p) {
            float L[16];
#pragma unroll
            for (int j = 0; j < 16; ++j) L[j] = NINF;
            bf16x8 qf[8];
#pragma unroll
            for (int s8 = 0; s8 < 8; ++s8) qf[s8] = *(const bf16x8*)(qry + (size_t)t * 2048 + h * 256 + p * 128 + 16 * s8 + 8 * hf);
#pragma unroll
            for (int kb = 0; kb < 4; ++kb) {
                const bf16* kp = skb + ((size_t)(h * 2 + p) * 128 + kb * 32 + c) * 128 + 8 * hf;
                f32x16 z;
#pragma unroll
                for (int r = 0; r < 16; ++r) z[r] = 0.f;
#pragma unroll
                for (int s8 = 0; s8 < 8; ++s8) { const bf16x8 kf = *(const bf16x8*)(kp + 16 * s8); z = __builtin_amdgcn_mfma_f32_32x32x16_bf16(kf, qf[s8], z, 0, 0, 0); }
#pragma unroll
                for (int r = 0; r < 16; ++r) { const unsigned n = (unsigned)(kb * 32 + (r & 3) + 8 * (r >> 2));
                    const float pk = __uint_as_float(((__float_as_uint(z[r]) & 0xffffff80u) | hf4) | n); PKINS(pk, L); }
            }
            float P[16];
#pragma unroll
            for (int j = 0; j < 16; ++j) P[j] = __shfl_xor(L[j], 32);
#pragma unroll
            for (int j = 0; j < 16; ++j) PKINS(P[j], L);
#pragma unroll
            for (int j = 0; j < 16; ++j) { if (p == 0) LA[j] = L[j]; else LB[j] = L[j]; }
        }
        float best[16];
#pragma unroll
        for (int j = 0; j < 16; ++j) best[j] = NINF;
#pragma unroll
        for (int i = 0; i < 16; ++i)
#pragma unroll
            for (int j = 0; j < 16; ++j) if ((i + 1) * (j + 1) <= 16) { const float sm = LA[i] + LB[j];
                const float pk = __uint_as_float((__float_as_uint(sm) & 0xffffff00u) | (unsigned)(i * 16 + j)); PKINS(pk, best); }
        asm volatile("s_waitcnt lgkmcnt(0)" ::: "memory");
#pragma unroll
        for (int j = 0; j < 16; ++j) wl[16 * hf + j] = hf ? LB[j] : LA[j];
        asm volatile("s_waitcnt lgkmcnt(0)" ::: "memory");
        const float mx = __uint_as_float(__float_as_uint(best[0]) & 0xffffff00u);
        float ev[8]; unsigned id[8]; float sum = 0.f;
#pragma unroll
        for (int k = 0; k < 8; ++k) { const unsigned bk = __float_as_uint(hf ? best[k + 8] : best[k]); const unsigned code = bk & 255u;
            const unsigned ia = __float_as_uint(wl[code >> 4]) & 127u, ib = __float_as_uint(wl[16 + (code & 15u)]) & 127u; id[k] = ia * 128u + ib;
            ev[k] = __expf(__uint_as_float(bk & 0xffffff00u) - mx); sum += ev[k]; }
        sum += __shfl_xor(sum, 32);
        const float inv = 1.0f / sum;
        float* gp = pgate + (size_t)t * 128 + h * 16 + 8 * hf; int* ip = pidx + (size_t)t * 128 + h * 16 + 8 * hf;
        *(f32x4*)gp = (f32x4){ev[0] * inv, ev[1] * inv, ev[2] * inv, ev[3] * inv}; *(f32x4*)(gp + 4) = (f32x4){ev[4] * inv, ev[5] * inv, ev[6] * inv, ev[7] * inv};
        *(v4u*)ip = (v4u){id[0], id[1], id[2], id[3]}; *(v4u*)(ip + 4) = (v4u){id[4], id[5], id[6], id[7]};
        asm volatile("s_waitcnt lgkmcnt(0)" ::: "memory");
    }
}
__device__ __forceinline__ void ph7_peer_naive(Frame& F) {
    const int gw = F.vcu * NWAVES + F.wave, NGW = F.G * NWAVES;
    const float* x1 = WSP(float, WS_X1); const int* pidx = WSP(int, WS_PIDX); const float* pgate = WSP(float, WS_PGATE);
    for (int m = gw; m < T; m += NGW) {
        f32x4 xv[4], acc[4];
#pragma unroll
        for (int i = 0; i < 4; ++i) { xv[i] = *(const f32x4*)(x1 + (size_t)m * DM + 256 * i + 4 * F.lane); acc[i] = (f32x4){0.f, 0.f, 0.f, 0.f}; }
        for (int k = 0; k < 128; ++k) {
            const int e = __builtin_amdgcn_readfirstlane(pidx[(size_t)m * 128 + k]); const float g = pgate[(size_t)m * 128 + k];
            const float* ur = F.pu + (size_t)e * DM; const float* vr = F.pv + (size_t)e * DM;
            float p = 0.f;
#pragma unroll
            for (int i = 0; i < 4; ++i) { const f32x4 uu = *(const f32x4*)(ur + 256 * i + 4 * F.lane); p += (uu.x * xv[i].x + uu.y * xv[i].y) + (uu.z * xv[i].z + uu.w * xv[i].w); }
            p = wave_sum(p);
            const float w = g * 0.5f * p * (1.0f + erff(p * 0.70710678118654752f));
#pragma unroll
            for (int i = 0; i < 4; ++i) acc[i] += *(const f32x4*)(vr + 256 * i + 4 * F.lane) * w;
        }
        float s = 0.f;
#pragma unroll
        for (int i = 0; i < 4; ++i) { acc[i] = xv[i] * ALPHA + acc[i]; s += (acc[i].x + acc[i].y) + (acc[i].z + acc[i].w); }
        const float mean = wave_sum(s) * (1.0f / DM); float q = 0.f;
#pragma unroll
        for (int i = 0; i < 4; ++i) { acc[i] = acc[i] - mean; q += (acc[i].x * acc[i].x + acc[i].y * acc[i].y) + (acc[i].z * acc[i].z + acc[i].w * acc[i].w); }
        const float rstd = rsqrtf(wave_sum(q) * (1.0f / DM) + EPS);
#pragma unroll
        for (int i = 0; i < 4; ++i) { const int c = 256 * i + 4 * F.lane;
            *(f32x4*)(F.out + (size_t)m * DM + c) = acc[i] * rstd * *(const f32x4*)(F.ln2_g + c) + *(const f32x4*)(F.ln2_b + c); }
    }
}


__device__ __forceinline__ float gelu_erf(float p) { return 0.5f * p * (1.0f + erff(p * 0.70710678118654752f)); }
__device__ __forceinline__ void ph7_peer(Frame& F) {
    const int gw = F.vcu * NWAVES + F.wave, NGW = F.G * NWAVES, lane = F.lane;
    const float* x1 = WSP(float, WS_X1); const int* pidx = WSP(int, WS_PIDX); const float* pgate = WSP(float, WS_PGATE);
    const bf16* UB = WSP(bf16, WS_UB); const bf16* VB = WSP(bf16, WS_VB);
    const bool b5 = (lane & 32) != 0, b4 = (lane & 16) != 0, b3 = (lane & 8) != 0;
    for (int m = gw; m < T; m += NGW) {
        float xv[16], acc[16];
#pragma unroll
        for (int i = 0; i < 2; ++i) { const f32x4 a = *(const f32x4*)(x1 + (size_t)m * DM + 512 * i + 8 * lane), b = *(const f32x4*)(x1 + (size_t)m * DM + 512 * i + 8 * lane + 4);
            xv[8 * i] = a.x; xv[8 * i + 1] = a.y; xv[8 * i + 2] = a.z; xv[8 * i + 3] = a.w; xv[8 * i + 4] = b.x; xv[8 * i + 5] = b.y; xv[8 * i + 6] = b.z; xv[8 * i + 7] = b.w; }
#pragma unroll
        for (int i = 0; i < 16; ++i) acc[i] = 0.f;
        for (int k0 = 0; k0 < 128; k0 += 8) {
            const int ei = pidx[(size_t)m * 128 + k0 + (lane >> 3)]; const float gi = pgate[(size_t)m * 128 + k0 + (lane >> 3)];
            v4u uw[8][2], vw[8][2];
#pragma unroll
            for (int j = 0; j < 8; ++j) { const int e = __builtin_amdgcn_readlane(ei, 8 * j);
#pragma unroll
                for (int i = 0; i < 2; ++i) { uw[j][i] = *(const v4u*)(UB + (size_t)e * DM + 512 * i + 8 * lane); vw[j][i] = *(const v4u*)(VB + (size_t)e * DM + 512 * i + 8 * lane); } }
            float p[8];
#pragma unroll
            for (int j = 0; j < 8; ++j) { float a = 0.f;
#pragma unroll
                for (int i = 0; i < 2; ++i)
#pragma unroll
                    for (int q = 0; q < 4; ++q) { const unsigned w = uw[j][i][q]; a += __uint_as_float(w << 16) * xv[8 * i + 2 * q] + __uint_as_float(w & 0xffff0000u) * xv[8 * i + 2 * q + 1]; }
                p[j] = a; }
            float r1[4], r2[2];
#pragma unroll
            for (int j = 0; j < 4; ++j) r1[j] = (b5 ? p[j + 4] : p[j]) + __shfl_xor(b5 ? p[j] : p[j + 4], 32);
#pragma unroll
            for (int j = 0; j < 2; ++j) r2[j] = (b4 ? r1[j + 2] : r1[j]) + __shfl_xor(b4 ? r1[j] : r1[j + 2], 16);
            float r3 = (b3 ? r2[1] : r2[0]) + __shfl_xor(b3 ? r2[0] : r2[1], 8);
            r3 += __shfl_xor(r3, 4); r3 += __shfl_xor(r3, 2); r3 += __shfl_xor(r3, 1);
            const float wl = gi * gelu_erf(r3);
#pragma unroll
            for (int j = 0; j < 8; ++j) { const float w = __int_as_float(__builtin_amdgcn_readlane(__float_as_int(wl), 8 * j));
#pragma unroll
                for (int i = 0; i < 2; ++i)
#pragma unroll
                    for (int q = 0; q < 4; ++q) { const unsigned vwd = vw[j][i][q]; acc[8 * i + 2 * q] += w * __uint_as_float(vwd << 16); acc[8 * i + 2 * q + 1] += w * __uint_as_float(vwd & 0xffff0000u); } }
        }
        float s = 0.f;
#pragma unroll
        for (int i = 0; i < 16; ++i) { acc[i] = xv[i] * ALPHA + acc[i]; s += acc[i]; }
        const float mean = wave_sum(s) * (1.0f / DM); float q = 0.f;
#pragma unroll
        for (int i = 0; i < 16; ++i) { acc[i] -= mean; q += acc[i] * acc[i]; }
        const float rstd = rsqrtf(wave_sum(q) * (1.0f / DM) + EPS);
#pragma unroll
        for (int i = 0; i < 2; ++i)
#pragma unroll
            for (int hh = 0; hh < 2; ++hh) { const int c = 512 * i + 8 * lane + 4 * hh; const f32x4 g = *(const f32x4*)(F.ln2_g + c), bb = *(const f32x4*)(F.ln2_b + c);
                *(f32x4*)(F.out + (size_t)m * DM + c) = (f32x4){acc[8 * i + 4 * hh] * rstd * g.x + bb.x, acc[8 * i + 4 * hh + 1] * rstd * g.y + bb.y, acc[8 * i + 4 * hh + 2] * rstd * g.z + bb.z, acc[8 * i + 4 * hh + 3] * rstd * g.w + bb.w}; }
    }
}

__device__ __forceinline__ void ph9_peer_fp8(Frame& F) {
    const int gw = F.vcu * NWAVES + F.wave, NGW = F.G * NWAVES, lane = F.lane;
    const float* x1 = WSP(float, WS_X1); const int* pidx = WSP(int, WS_PIDX); const float* pgate = WSP(float, WS_PGATE);
    const unsigned char* U8 = F.ws + WS_U8; const unsigned char* V8 = F.ws + WS_V8; const float* rsu = WSP(float, WS_RSU); const float* rsv = WSP(float, WS_RSV);
    const bool b5 = (lane & 32) != 0, b4 = (lane & 16) != 0, b3 = (lane & 8) != 0, b2 = (lane & 4) != 0;
    for (int m = gw; m < T; m += NGW) {
        f32x2 xv[8], acc[8];
#pragma unroll
        for (int i = 0; i < 4; ++i) { const f32x4 a = *(const f32x4*)(x1 + (size_t)m * DM + 16 * lane + 4 * i); xv[2 * i] = (f32x2){a.x, a.y}; xv[2 * i + 1] = (f32x2){a.z, a.w}; }
#pragma unroll
        for (int i = 0; i < 8; ++i) acc[i] = (f32x2){0.f, 0.f};
        for (int k0 = 0; k0 < 128; k0 += 16) {
            const int ei = pidx[(size_t)m * 128 + k0 + (lane >> 2)]; const float gi = pgate[(size_t)m * 128 + k0 + (lane >> 2)];
            const float su = rsu[ei], sv = rsv[ei];
            v4u uw[16], vw[16];
#pragma unroll
            for (int j = 0; j < 16; ++j) { const int e = __builtin_amdgcn_readlane(ei, 4 * j);
                uw[j] = *(const v4u*)(U8 + (size_t)e * DM + 16 * lane); vw[j] = *(const v4u*)(V8 + (size_t)e * DM + 16 * lane); }
            float p[16];
#pragma unroll
            for (int j = 0; j < 16; ++j) { f32x2 a = (f32x2){0.f, 0.f};
#pragma unroll
                for (int q = 0; q < 4; ++q) { a += __builtin_amdgcn_cvt_pk_f32_fp8((int)uw[j][q], false) * xv[2 * q]; a += __builtin_amdgcn_cvt_pk_f32_fp8((int)uw[j][q], true) * xv[2 * q + 1]; }
                p[j] = a.x + a.y; }
            float r1[8], r2[4], r3[2];
#pragma unroll
            for (int j = 0; j < 8; ++j) r1[j] = (b5 ? p[j + 8] : p[j]) + __shfl_xor(b5 ? p[j] : p[j + 8], 32);
#pragma unroll
            for (int j = 0; j < 4; ++j) r2[j] = (b4 ? r1[j + 4] : r1[j]) + __shfl_xor(b4 ? r1[j] : r1[j + 4], 16);
#pragma unroll
            for (int j = 0; j < 2; ++j) r3[j] = (b3 ? r2[j + 2] : r2[j]) + __shfl_xor(b3 ? r2[j] : r2[j + 2], 8);
            float r4 = (b2 ? r3[1] : r3[0]) + __shfl_xor(b2 ? r3[0] : r3[1], 4);
            r4 += __shfl_xor(r4, 2); r4 += __shfl_xor(r4, 1);
            const float wl = gi * gelu_erf(r4 * su) * sv;
#pragma unroll
            for (int j = 0; j < 16; ++j) { const float w = __int_as_float(__builtin_amdgcn_readlane(__float_as_int(wl), 4 * j)); const f32x2 w2 = (f32x2){w, w};
#pragma unroll
                for (int q = 0; q < 4; ++q) { acc[2 * q] += __builtin_amdgcn_cvt_pk_f32_fp8((int)vw[j][q], false) * w2; acc[2 * q + 1] += __builtin_amdgcn_cvt_pk_f32_fp8((int)vw[j][q], true) * w2; } }
        }
        float s = 0.f;
#pragma unroll
        for (int i = 0; i < 8; ++i) { acc[i] = xv[i] * ALPHA + acc[i]; s += acc[i].x + acc[i].y; }
        const float mean = wave_sum(s) * (1.0f / DM); float q = 0.f;
#pragma unroll
        for (int i = 0; i < 8; ++i) { acc[i] = acc[i] - mean; q += acc[i].x * acc[i].x + acc[i].y * acc[i].y; }
        const float rstd = rsqrtf(wave_sum(q) * (1.0f / DM) + EPS);
#pragma unroll
        for (int i = 0; i < 4; ++i) { const int c = 16 * lane + 4 * i; const f32x4 g = *(const f32x4*)(F.ln2_g + c), bb = *(const f32x4*)(F.ln2_b + c);
            *(f32x4*)(F.out + (size_t)m * DM + c) = (f32x4){acc[2 * i].x * rstd * g.x + bb.x, acc[2 * i].y * rstd * g.y + bb.y, acc[2 * i + 1].x * rstd * g.z + bb.z, acc[2 * i + 1].y * rstd * g.w + bb.w}; }
    }
}

__device__ __forceinline__ void ph9_peer_sliced(Frame& F) {
    const int lane = F.lane, seg = lane & 7, eg = lane >> 3;
    const bool b0 = (lane & 1) != 0, b1 = (lane & 2) != 0, b2 = (lane & 4) != 0, b3 = (lane & 8) != 0, b4 = (lane & 16) != 0, b5 = (lane & 32) != 0;
    const int gw = F.vcu * NWAVES + F.wave, NGW = F.G * NWAVES;
    const float* x1 = WSP(float, WS_X1); const int* pidx = WSP(int, WS_PIDX); const float* pgate = WSP(float, WS_PGATE);
    const unsigned char* U8 = F.ws + WS_U8; const unsigned char* V8 = F.ws + WS_V8; const float* rsu = WSP(float, WS_RSU); const float* rsv = WSP(float, WS_RSV);
    unsigned* il = (unsigned*)(F.lds + F.wave * 8192); float* hw = (float*)(F.lds + F.wave * 8192 + 4096);
    const int kU = 16 * eg + 8 * (int)b0 + 4 * (int)b1 + 2 * (int)b2;
    const int dV = 16 * seg + 8 * (int)b3 + 4 * (int)b4 + 2 * (int)b5;
    for (int m0 = gw * 8; m0 < T; m0 += NGW * 8) {
        asm volatile("s_waitcnt lgkmcnt(0)" ::: "memory");
#pragma unroll
        for (int tk = 0; tk < 8; ++tk) { const size_t m = m0 + tk;
            il[tk * 128 + lane] = (unsigned)pidx[m * 128 + lane] * 1024u; il[tk * 128 + 64 + lane] = (unsigned)pidx[m * 128 + 64 + lane] * 1024u;
            hw[tk * 128 + lane] = 0.f; hw[tk * 128 + 64 + lane] = 0.f; }
        asm volatile("s_waitcnt lgkmcnt(0)" ::: "memory");
        for (int sl = 0; sl < 8; ++sl) {
            for (int tk = 0; tk < 8; ++tk) {
                const size_t m = m0 + tk;
                v4u e4[4]; f32x4 xq[4];
#pragma unroll
                for (int q = 0; q < 4; ++q) { e4[q] = *(const v4u*)(il + tk * 128 + 16 * eg + 4 * q); xq[q] = *(const f32x4*)(x1 + m * DM + 128 * sl + 16 * seg + 4 * q); }
                v4u uw[16];
#pragma unroll
                for (int i = 0; i < 16; ++i) uw[i] = *(const v4u*)(U8 + (size_t)e4[i >> 2][i & 3] + 128 * sl + 16 * seg);
                float p[16];
#pragma unroll
                for (int i = 0; i < 16; ++i) { f32x2 a = (f32x2){0.f, 0.f};
#pragma unroll
                    for (int q = 0; q < 4; ++q) { a += __builtin_amdgcn_cvt_pk_f32_fp8((int)uw[i][q], false) * (f32x2){xq[q].x, xq[q].y}; a += __builtin_amdgcn_cvt_pk_f32_fp8((int)uw[i][q], true) * (f32x2){xq[q].z, xq[q].w}; }
                    p[i] = a.x + a.y; }
                float r1[8], r2[4], r3[2];
#pragma unroll
                for (int i = 0; i < 8; ++i) r1[i] = (b0 ? p[i + 8] : p[i]) + __shfl_xor(b0 ? p[i] : p[i + 8], 1);
#pragma unroll
                for (int i = 0; i < 4; ++i) r2[i] = (b1 ? r1[i + 4] : r1[i]) + __shfl_xor(b1 ? r1[i] : r1[i + 4], 2);
#pragma unroll
                for (int i = 0; i < 2; ++i) r3[i] = (b2 ? r2[i + 2] : r2[i]) + __shfl_xor(b2 ? r2[i] : r2[i + 2], 4);
                f32x2* hp = (f32x2*)(hw + tk * 128 + kU); const f32x2 old = *hp; *hp = (f32x2){old.x + r3[0], old.y + r3[1]};
            }
        }
        asm volatile("s_waitcnt lgkmcnt(0)" ::: "memory");
#pragma unroll
        for (int tk = 0; tk < 8; ++tk) { const size_t m = m0 + tk;
#pragma unroll
            for (int hh = 0; hh < 2; ++hh) { const int k = lane + 64 * hh; const unsigned e = il[tk * 128 + k] >> 10;
                hw[tk * 128 + k] = pgate[m * 128 + k] * gelu_erf(hw[tk * 128 + k] * rsu[e]) * rsv[e]; } }
        asm volatile("s_waitcnt lgkmcnt(0)" ::: "memory");
        for (int sl = 0; sl < 8; ++sl) {
            for (int tk = 0; tk < 8; ++tk) {
                const size_t m = m0 + tk;
                v4u e4[4]; f32x4 w4[4];
#pragma unroll
                for (int q = 0; q < 4; ++q) { e4[q] = *(const v4u*)(il + tk * 128 + 16 * eg + 4 * q); w4[q] = *(const f32x4*)(hw + tk * 128 + 16 * eg + 4 * q); }
                const f32x2 xr = *(const f32x2*)(x1 + m * DM + 128 * sl + dV);
                v4u vw[16];
#pragma unroll
                for (int i = 0; i < 16; ++i) vw[i] = *(const v4u*)(V8 + (size_t)e4[i >> 2][i & 3] + 128 * sl + 16 * seg);
                f32x2 acc[8];
#pragma unroll
                for (int q = 0; q < 8; ++q) acc[q] = (f32x2){0.f, 0.f};
#pragma unroll
                for (int i = 0; i < 16; ++i) { const float w = w4[i >> 2][i & 3]; const f32x2 w2 = (f32x2){w, w};
#pragma unroll
                    for (int q = 0; q < 4; ++q) { acc[2 * q] += __builtin_amdgcn_cvt_pk_f32_fp8((int)vw[i][q], false) * w2; acc[2 * q + 1] += __builtin_amdgcn_cvt_pk_f32_fp8((int)vw[i][q], true) * w2; } }
                float a[16];
#pragma unroll
                for (int q = 0; q < 8; ++q) { a[2 * q] = acc[q].x; a[2 * q + 1] = acc[q].y; }
                float r1[8], r2[4], r3[2];
#pragma unroll
                for (int i = 0; i < 8; ++i) r1[i] = (b3 ? a[i + 8] : a[i]) + __shfl_xor(b3 ? a[i] : a[i + 8], 8);
#pragma unroll
                for (int i = 0; i < 4; ++i) r2[i] = (b4 ? r1[i + 4] : r1[i]) + __shfl_xor(b4 ? r1[i] : r1[i + 4], 16);
#pragma unroll
                for (int i = 0; i < 2; ++i) r3[i] = (b5 ? r2[i + 2] : r2[i]) + __shfl_xor(b5 ? r2[i] : r2[i + 2], 32);
                *(f32x2*)(F.out + m * DM + 128 * sl + dV) = (f32x2){xr.x * ALPHA + r3[0], xr.y * ALPHA + r3[1]};
            }
        }
        asm volatile("s_waitcnt vmcnt(0)" ::: "memory");
        for (int tk = 0; tk < 8; ++tk) { const size_t m = m0 + tk;
            f32x4 y[4]; float sm = 0.f;
#pragma unroll
            for (int i = 0; i < 4; ++i) { y[i] = *(const f32x4*)(F.out + m * DM + 256 * i + 4 * lane); sm += (y[i].x + y[i].y) + (y[i].z + y[i].w); }
            const float mean = wave_sum(sm) * (1.0f / DM); float q = 0.f;
#pragma unroll
            for (int i = 0; i < 4; ++i) { y[i] = y[i] - mean; q += (y[i].x * y[i].x + y[i].y * y[i].y) + (y[i].z * y[i].z + y[i].w * y[i].w); }
            const float rstd = rsqrtf(wave_sum(q) * (1.0f / DM) + EPS);
#pragma unroll
            for (int i = 0; i < 4; ++i) { const int c = 256 * i + 4 * lane; *(f32x4*)(F.out + m * DM + c) = y[i] * rstd * *(const f32x4*)(F.ln2_g + c) + *(const f32x4*)(F.ln2_b + c); }
        }
    }
}
struct Args { const float* in[15]; float* out; unsigned char* ws; int ph_lo, ph_hi, li, pad; };
__global__ void __launch_bounds__(NTHR, 2) mk_fwd(Args args) {
    extern __shared__ __attribute__((aligned(16))) unsigned char lds[];
    Frame F;
    F.lds = lds; F.tid = threadIdx.x; F.lane = F.tid & 63; F.wave = __builtin_amdgcn_readfirstlane(F.tid >> 6);
    F.G = gridDim.x; { const int bx = blockIdx.x; F.vcu = (F.G % 8 == 0) ? (bx % 8) * (F.G / 8) + bx / 8 : bx; }
    F.x = args.in[0]; F.w_in = args.in[1]; F.w_gate = args.in[2]; F.b_gate = args.in[3]; F.gla_g = args.in[4]; F.sb_g = args.in[5]; F.w_out = args.in[6];
    F.ln1_g = args.in[7]; F.ln1_b = args.in[8]; F.w_q = args.in[9]; F.sub_keys = args.in[10]; F.pu = args.in[11]; F.pv = args.in[12]; F.ln2_g = args.in[13]; F.ln2_b = args.in[14];
    F.out = args.out; F.ws = args.ws;
    volatile LAS unsigned* MISC = (volatile LAS unsigned*)((LAS unsigned char*)lds + MISC_OFF);
    if (F.tid < 32) MISC[F.tid] = 0u;
    __syncthreads();
    unsigned* barw = (unsigned*)(F.ws + WS_CTL) + CW_BAR + args.li * XCD_BAR_WORDS;
    XcdBarrier bar; bar.bar = barw; bar.x = 0; bar.st = nullptr;
    const int lo = args.ph_lo, hi = args.ph_hi;
    if (hi - lo > 1) bar = xcd_barrier_post(barw, MISC + 8);
#ifndef PH_MASK
#define PH_MASK 0x3ff
#endif
#define IN(k) (((PH_MASK >> (k)) & 1) && lo <= (k) && (k) < hi)
#ifndef REP_PHASE
#define REP_PHASE -1
#endif
#ifndef REP_N
#define REP_N 2
#endif
#define SEAM(k) do { if (IN(k) && IN((k) + 1)) xcd_barrier(bar); } while (0)
#ifndef NAIVE_MASK
#define NAIVE_MASK 0x00
#endif
#define NV(k) ((NAIVE_MASK >> (k)) & 1)
    LAS unsigned char* const ldsl = (LAS unsigned char*)lds;
#define PH0 ph0_prologue(F)
#define PH1 do { pg8::Gemm g{WSP(bf16, WS_XB), WSP(bf16, WS_WTIN), T, NPJ, DM}; pg8::StaticOrder S; S.init(T, NPJ, F.G, (int)blockIdx.x); \
        pg8::EpiBf16<0> E{WSP(bf16, WS_PROJ), NPJ, nullptr, 0, 0, 1.f}; pg8::gemm_phase<pg8::EpiBf16<0>, pg8::StaticOrder, true, true>(ldsl, g, S, E); } while (0)
#define PH2 do { gla_mfma_pass<false>(F); ph_sb_mfma(F); } while (0)
#define PH3 gla_scan(F)
#define PH4 gla_mfma_pass<true>(F)
#define PH5 do { pg8::Gemm g{WSP(bf16, WS_CAT), WSP(bf16, WS_WTOUT), T, DM, DM}; pg8::StaticOrder S; S.init(T, DM, F.G, (int)blockIdx.x); \
        pg8::EpiF32 E{F.out, DM}; pg8::gemm_phase<pg8::EpiF32, pg8::StaticOrder, true, true>(ldsl, g, S, E); } while (0)
#define PH6 ph4_ln1(F)
#define PH7 do { pg8::Gemm g{WSP(bf16, WS_X1B), WSP(bf16, WS_WTQ), T, 2048, DM}; pg8::StaticOrder S; S.init(T, 2048, F.G, (int)blockIdx.x); \
        pg8::EpiBf16<0> E{WSP(bf16, WS_QRY), 2048, nullptr, 0, 0, 1.f}; pg8::gemm_phase<pg8::EpiBf16<0>, pg8::StaticOrder, true, true>(ldsl, g, S, E); } while (0)
#define PH8 ph8_topk(F)
#ifndef PEER_SLICED
#define PEER_SLICED 1
#endif
#define PH9 do { if (PEER_SLICED) ph9_peer_sliced(F); else ph9_peer_fp8(F); } while (0)
#define RUN(k, BODY) do { if (IN(k)) { BODY; if (REP_PHASE == (k)) { for (int rep_ = 0; rep_ < REP_N; ++rep_) { xcd_barrier(bar); BODY; } } } } while (0)
    RUN(0, PH0); SEAM(0);
    RUN(1, PH1); SEAM(1);
    RUN(2, PH2); SEAM(2);
    RUN(3, PH3); SEAM(3);
    RUN(4, PH4); SEAM(4);
    RUN(5, PH5); SEAM(5);
    RUN(6, PH6); SEAM(6);
    RUN(7, PH7); SEAM(7);
    RUN(8, PH8); SEAM(8);
    RUN(9, PH9);
#undef IN
#undef SEAM
}

extern "C" void kernel_launch(void* const* d_in, const int* in_sizes, int n_in, void* d_out, int out_size, void* d_ws, size_t ws_size, hipStream_t stream) {
    static int grid = 0;
    if (grid == 0) {
        if (n_in != 15 || in_sizes[0] != T * DM || out_size != T * DM || ws_size < WS_END) {
            fprintf(stderr, "kernel_launch: unexpected problem: n_in %d in0 %d out %d ws %zu (need %zu)\n", n_in, n_in > 0 ? in_sizes[0] : -1, out_size, ws_size, (size_t)WS_END); grid = -1; return; }
        int dev = 0, cus = 0;
        if (hipGetDevice(&dev) != hipSuccess || hipDeviceGetAttribute(&cus, hipDeviceAttributeMultiprocessorCount, dev) != hipSuccess) { grid = -1; return; }
        if (hipFuncSetAttribute((const void*)mk_fwd, hipFuncAttributeMaxDynamicSharedMemorySize, LDS_BYTES) != hipSuccess) { fprintf(stderr, "kernel_launch: hipFuncSetAttribute failed\n"); grid = -1; return; }
        (void)hipGetLastError();
        grid = cus;
    }
    if (grid < 0) return;
    if (hipMemsetAsync((char*)d_ws + WS_CTL, 0, CTL_ZERO_BYTES, stream) != hipSuccess) { fprintf(stderr, "kernel_launch: memset failed\n"); return; }
    Args a{};
    for (int i = 0; i < 15; ++i) a.in[i] = (const float*)d_in[i];
    a.out = (float*)d_out; a.ws = (unsigned char*)d_ws;
    constexpr int NL = MK_N_LAUNCHES;
    for (int li = 0; li < NL; ++li) {
        a.ph_lo = (NL == 1) ? 0 : li; a.ph_hi = (NL == 1) ? NPHASE : li + 1; a.li = li;
        hipLaunchKernelGGL(mk_fwd, dim3(grid), dim3(NTHR), LDS_BYTES, stream, a);
        const hipError_t le = hipPeekAtLastError();
        if (le != hipSuccess) { fprintf(stderr, "kernel_launch: launch %d failed: %s\n", li, hipGetErrorName(le)); break; }
    }
}
```
